# Optimizing an MI355X kernel written in HIP

```python
import jax, jax.numpy as jnp
from jax import lax
import numpy as np

D_MODEL = 1024
BATCH = 2
SEQ = 16384
DEPTH = 2

N_MIXERS = 2
N_HEADS = 16
HEAD_DIM = 64
ATTN_WIDTH = N_HEADS * HEAD_DIM
NSA_KV_GROUPS = 4
NSA_Q_PER_GROUP = N_HEADS // NSA_KV_GROUPS
CMP_BLOCK = 32
CMP_STRIDE = 16
CMP_HIDDEN = 2 * HEAD_DIM
SLC_BLOCK = 64
SLC_TOPK = 16
WINDOW = 512
FORCE_SCORE = 1.0e4
NSA_IN_COLS = ATTN_WIDTH + 6 * NSA_KV_GROUPS * HEAD_DIM + 3 * N_HEADS
FOX_IN_COLS = 3 * ATTN_WIDTH + N_HEADS
FOX_F_BIAS_INIT = 3.0
Q_BLOCK = 128
ROPE_THETA = 10000.0
PEER_HEADS = 8
PEER_N_KEYS = 128
PEER_N_EXPERTS = PEER_N_KEYS * PEER_N_KEYS
PEER_QUERY_DIM = 256
PEER_TOPK = 16
PEER_TOKEN_CHUNK = 128
RMS_EPS = 1e-6
NEG_INF = -1e30

kernel_name = 'hybrid_nsa_fox_peer'


def rms_norm(x, g):
    xf = x.astype(jnp.float32)
    y = xf * lax.rsqrt(jnp.mean(xf * xf, axis=-1, keepdims=True) + RMS_EPS)
    return (y * g.astype(jnp.float32)).astype(x.dtype)


def rope(x):
    seq = x.shape[1]
    half = HEAD_DIM // 2
    inv_freq = ROPE_THETA ** (-jnp.arange(half, dtype=jnp.float32) / half)
    ang = jnp.arange(seq, dtype=jnp.float32)[:, None] * inv_freq[None, :]
    cos = jnp.cos(ang)[None, :, None, :]
    sin = jnp.sin(ang)[None, :, None, :]
    x1 = x[..., :half].astype(jnp.float32)
    x2 = x[..., half:].astype(jnp.float32)
    return jnp.concatenate([x1 * cos - x2 * sin, x2 * cos + x1 * sin], axis=-1).astype(x.dtype)


def masked_softmax(s, mask):
    s = jnp.where(mask, s.astype(jnp.float32), NEG_INF)
    m = jnp.max(s, axis=-1, keepdims=True)
    p = jnp.exp(s - m) * mask
    return p / jnp.maximum(jnp.sum(p, axis=-1, keepdims=True), 1e-30)


def compress_blocks(tok, pe, w1, w2):
    seq = tok.shape[1]
    n_cmp = (seq - CMP_BLOCK) // CMP_STRIDE + 1
    idx = np.arange(n_cmp)[:, None] * CMP_STRIDE + np.arange(CMP_BLOCK)[None, :]
    blk = tok[:, idx] + jnp.transpose(pe, (1, 0, 2))[None, None]
    hid = jax.nn.gelu(jnp.einsum('bclgd,gldh->bgch', blk, w1))
    return jnp.einsum('bgch,ghd->bgcd', hid, w2)


def cmp_to_slc_matrix(n_cmp, n_slc):
    i = np.arange(n_cmp)[:, None]
    j = np.arange(n_slc)[None, :]
    lo = np.maximum(i * CMP_STRIDE, j * SLC_BLOCK)
    hi = np.minimum(i * CMP_STRIDE + CMP_BLOCK, (j + 1) * SLC_BLOCK)
    return jnp.asarray(np.maximum(hi - lo, 0).astype(np.float32) / CMP_BLOCK)


def nsa_mixer(x, w_in, pe_k, w1_k, w2_k, pe_v, w1_v, w2_v, w_out):
    B, S, _ = x.shape
    G, R, hd = NSA_KV_GROUPS, NSA_Q_PER_GROUP, HEAD_DIM
    kvd = G * hd
    proj = x @ w_in
    q = rope(proj[..., :ATTN_WIDTH].reshape(B, S, N_HEADS, hd))
    kv = proj[..., ATTN_WIDTH:ATTN_WIDTH + 6 * kvd].reshape(B, S, 6, G, hd)
    gates = jax.nn.sigmoid(proj[..., ATTN_WIDTH + 6 * kvd:].astype(jnp.float32))
    gates = gates.reshape(B, S, 3, G, R).transpose(0, 2, 3, 4, 1).astype(x.dtype)
    k_cmp = compress_blocks(rope(kv[:, :, 0]), pe_k, w1_k, w2_k)
    v_cmp = compress_blocks(kv[:, :, 1], pe_v, w1_v, w2_v)
    k_slc, v_slc = rope(kv[:, :, 2]), kv[:, :, 3]
    k_win, v_win = rope(kv[:, :, 4]), kv[:, :, 5]
    n_cmp = k_cmp.shape[2]
    n_slc = S // SLC_BLOCK
    n_sel = min(SLC_TOPK, n_slc)
    cmp_end = jnp.arange(n_cmp) * CMP_STRIDE + CMP_BLOCK - 1
    slc_map = cmp_to_slc_matrix(n_cmp, n_slc)
    q = q.reshape(B, S, G, R, hd).transpose(0, 2, 3, 1, 4) * (hd ** -0.5)
    k_blk = k_slc.reshape(B, n_slc, SLC_BLOCK, G, hd).transpose(0, 3, 1, 2, 4)
    v_blk = v_slc.reshape(B, n_slc, SLC_BLOCK, G, hd).transpose(0, 3, 1, 2, 4)
    pad = ((0, 0), (0, 0), (WINDOW, 0), (0, 0))
    k_win_p = jnp.pad(k_win.transpose(0, 2, 1, 3), pad)
    v_win_p = jnp.pad(v_win.transpose(0, 2, 1, 3), pad)
    bi = jnp.arange(B)[:, None, None, None]
    gi = jnp.arange(G)[None, :, None, None]
    blk_ids = jnp.arange(n_slc)
    win_off = jnp.arange(WINDOW + Q_BLOCK)

    def one_block(b_idx):
        t0 = b_idx * Q_BLOCK
        qb = lax.dynamic_slice_in_dim(q, t0, Q_BLOCK, axis=3)
        gb = lax.dynamic_slice_in_dim(gates, t0, Q_BLOCK, axis=4)
        t = t0 + jnp.arange(Q_BLOCK)
        s_c = jnp.einsum('bgrqd,bgcd->bgrqc', qb, k_cmp)
        p_c = masked_softmax(s_c, cmp_end[None, :] <= t[:, None])
        o_c = jnp.einsum('bgrqc,bgcd->bgrqd', p_c.astype(v_cmp.dtype), v_cmp)
        imp = jnp.einsum('bgrqc,cj->bgqj', p_c, slc_map)
        cur = t // SLC_BLOCK
        forced = (blk_ids[None, :] == 0) | (blk_ids[None, :] == cur[:, None]) | (blk_ids[None, :] == cur[:, None] - 1)
        causal_blk = blk_ids[None, :] <= cur[:, None]
        imp = jnp.where(forced, FORCE_SCORE, jnp.where(causal_blk, imp, -1.0))
        _, sel = lax.top_k(imp, n_sel)
        ks = k_blk[bi, gi, sel]
        vs = v_blk[bi, gi, sel]
        s_s = jnp.einsum('bgrqd,bgqknd->bgrqkn', qb, ks)
        pos_s = sel[..., None] * SLC_BLOCK + jnp.arange(SLC_BLOCK)
        m_s = (pos_s <= t[None, None, :, None, None]).reshape(B, G, 1, Q_BLOCK, n_sel * SLC_BLOCK)
        p_s = masked_softmax(s_s.reshape(B, G, R, Q_BLOCK, n_sel * SLC_BLOCK), m_s)
        p_s = p_s.reshape(B, G, R, Q_BLOCK, n_sel, SLC_BLOCK)
        o_s = jnp.einsum('bgrqkn,bgqknd->bgrqd', p_s.astype(vs.dtype), vs)
        kw = lax.dynamic_slice_in_dim(k_win_p, t0, WINDOW + Q_BLOCK, axis=2)
        vw = lax.dynamic_slice_in_dim(v_win_p, t0, WINDOW + Q_BLOCK, axis=2)
        pos_w = t0 - WINDOW + win_off
        m_w = (pos_w[None, :] >= 0) & (pos_w[None, :] <= t[:, None]) & (pos_w[None, :] > t[:, None] - WINDOW)
        p_w = masked_softmax(jnp.einsum('bgrqd,bgkd->bgrqk', qb, kw), m_w)
        o_w = jnp.einsum('bgrqk,bgkd->bgrqd', p_w.astype(vw.dtype), vw)
        return gb[:, 0][..., None] * o_c + gb[:, 1][..., None] * o_s + gb[:, 2][..., None] * o_w

    o = lax.map(one_block, jnp.arange(S // Q_BLOCK))
    o = o.transpose(1, 0, 4, 2, 3, 5).reshape(B, S, ATTN_WIDTH)
    return o @ w_out


def fox_mixer(x, w_in, f_bias, w_out):
    B, S, _ = x.shape
    hd = HEAD_DIM
    proj = x @ w_in
    q, k, v = [proj[..., i * ATTN_WIDTH:(i + 1) * ATTN_WIDTH].reshape(B, S, N_HEADS, hd).transpose(0, 2, 1, 3) for i in range(3)]
    q = q * (hd ** -0.5)
    log_f = jax.nn.log_sigmoid(proj[..., 3 * ATTN_WIDTH:].astype(jnp.float32) + f_bias.astype(jnp.float32))
    c = jnp.cumsum(log_f, axis=1).transpose(0, 2, 1)
    pos = jnp.arange(S)

    def one_block(b_idx):
        t0 = b_idx * Q_BLOCK
        qb = lax.dynamic_slice_in_dim(q, t0, Q_BLOCK, axis=2)
        cb = lax.dynamic_slice_in_dim(c, t0, Q_BLOCK, axis=2)
        t = t0 + jnp.arange(Q_BLOCK)
        s = jnp.einsum('bhqd,bhkd->bhqk', qb, k).astype(jnp.float32) + cb[..., None] - c[:, :, None, :]
        p = masked_softmax(s, pos[None, :] <= t[:, None])
        return jnp.einsum('bhqk,bhkd->bhqd', p.astype(v.dtype), v)

    o = lax.map(one_block, jnp.arange(S // Q_BLOCK))
    o = o.transpose(1, 0, 3, 2, 4).reshape(B, S, ATTN_WIDTH)
    return o @ w_out


def peer_ffn(x, w_q, sub_keys, u, v):
    B, S, D = x.shape
    hq = PEER_QUERY_DIM // 2
    q = (x @ w_q).reshape(B, S, PEER_HEADS, 2, hq)
    s_half = jnp.einsum('bshpc,hpkc->bshpk', q, sub_keys).astype(jnp.float32)
    top_s, top_i = lax.top_k(s_half, PEER_TOPK)
    cand_s = top_s[..., 0, :, None] + top_s[..., 1, None, :]
    cand_i = top_i[..., 0, :, None] * PEER_N_KEYS + top_i[..., 1, None, :]
    n_cand = PEER_TOPK * PEER_TOPK
    best_s, best_pos = lax.top_k(cand_s.reshape(B, S, PEER_HEADS, n_cand), PEER_TOPK)
    experts = jnp.take_along_axis(cand_i.reshape(B, S, PEER_HEADS, n_cand), best_pos, axis=-1)
    gate = jax.nn.softmax(best_s, axis=-1)
    n_chunks = (B * S) // PEER_TOKEN_CHUNK
    n_sel = PEER_HEADS * PEER_TOPK
    xs = (x.reshape(n_chunks, PEER_TOKEN_CHUNK, D),
          experts.reshape(n_chunks, PEER_TOKEN_CHUNK, n_sel),
          gate.reshape(n_chunks, PEER_TOKEN_CHUNK, n_sel))

    def one_chunk(args):
        xc, ec, gc = args
        h = jax.nn.gelu(jnp.einsum('ted,td->te', u[ec], xc))
        return jnp.einsum('te,ted->td', gc.astype(h.dtype) * h, v[ec])

    return lax.map(one_chunk, xs).reshape(B, S, D)


def setup_inputs(seed: int = 0) -> dict:
    key = jax.random.key(seed)
    ks = jax.random.split(key, 25)
    f32 = jnp.float32
    G = NSA_KV_GROUPS

    def nrm(k, shape, scale):
        return jax.random.normal(k, shape, f32) * scale

    def gain(k):
        return 1.0 + 0.02 * jax.random.normal(k, (D_MODEL,), f32)

    cmp_w1_shape = (G, CMP_BLOCK, HEAD_DIM, CMP_HIDDEN)
    cmp_w1_scale = (CMP_BLOCK * HEAD_DIM) ** -0.5
    keys_shape = (PEER_HEADS, 2, PEER_N_KEYS, PEER_QUERY_DIM // 2)
    return {
        'x': nrm(ks[0], (BATCH, SEQ, D_MODEL), 1.0),
        'l0_attn_norm': gain(ks[1]),
        'l0_w_in': nrm(ks[2], (D_MODEL, NSA_IN_COLS), D_MODEL ** -0.5),
        'l0_cmp_pe_k': nrm(ks[3], (G, CMP_BLOCK, HEAD_DIM), 0.02),
        'l0_cmp_w1_k': nrm(ks[4], cmp_w1_shape, cmp_w1_scale),
        'l0_cmp_w2_k': nrm(ks[5], (G, CMP_HIDDEN, HEAD_DIM), CMP_HIDDEN ** -0.5),
        'l0_cmp_pe_v': nrm(ks[6], (G, CMP_BLOCK, HEAD_DIM), 0.02),
        'l0_cmp_w1_v': nrm(ks[7], cmp_w1_shape, cmp_w1_scale),
        'l0_cmp_w2_v': nrm(ks[8], (G, CMP_HIDDEN, HEAD_DIM), CMP_HIDDEN ** -0.5),
        'l0_w_out': nrm(ks[9], (ATTN_WIDTH, D_MODEL), ATTN_WIDTH ** -0.5),
        'l0_ffn_norm': gain(ks[10]),
        'l0_peer_wq': nrm(ks[11], (D_MODEL, PEER_HEADS * PEER_QUERY_DIM), D_MODEL ** -0.5),
        'l0_peer_keys': nrm(ks[12], keys_shape, (PEER_QUERY_DIM // 2) ** -0.5),
        'l0_peer_u': nrm(ks[13], (PEER_N_EXPERTS, D_MODEL), D_MODEL ** -0.5),
        'l0_peer_v': nrm(ks[14], (PEER_N_EXPERTS, D_MODEL), D_MODEL ** -0.5),
        'l1_attn_norm': gain(ks[15]),
        'l1_w_in': nrm(ks[16], (D_MODEL, FOX_IN_COLS), D_MODEL ** -0.5),
        'l1_f_bias': FOX_F_BIAS_INIT + nrm(ks[17], (N_HEADS,), 0.1),
        'l1_w_out': nrm(ks[18], (ATTN_WIDTH, D_MODEL), ATTN_WIDTH ** -0.5),
        'l1_ffn_norm': gain(ks[19]),
        'l1_peer_wq': nrm(ks[20], (D_MODEL, PEER_HEADS * PEER_QUERY_DIM), D_MODEL ** -0.5),
        'l1_peer_keys': nrm(ks[21], keys_shape, (PEER_QUERY_DIM // 2) ** -0.5),
        'l1_peer_u': nrm(ks[22], (PEER_N_EXPERTS, D_MODEL), D_MODEL ** -0.5),
        'l1_peer_v': nrm(ks[23], (PEER_N_EXPERTS, D_MODEL), D_MODEL ** -0.5),
        'final_norm': gain(ks[24]),
    }


def reference(x, l0_attn_norm, l0_w_in, l0_cmp_pe_k, l0_cmp_w1_k, l0_cmp_w2_k, l0_cmp_pe_v, l0_cmp_w1_v, l0_cmp_w2_v, l0_w_out,
              l0_ffn_norm, l0_peer_wq, l0_peer_keys, l0_peer_u, l0_peer_v,
              l1_attn_norm, l1_w_in, l1_f_bias, l1_w_out,
              l1_ffn_norm, l1_peer_wq, l1_peer_keys, l1_peer_u, l1_peer_v,
              final_norm):
    mixers = (nsa_mixer, fox_mixer)
    attn_norms = (l0_attn_norm, l1_attn_norm)
    mixer_args = ((l0_w_in, l0_cmp_pe_k, l0_cmp_w1_k, l0_cmp_w2_k, l0_cmp_pe_v, l0_cmp_w1_v, l0_cmp_w2_v, l0_w_out),
                  (l1_w_in, l1_f_bias, l1_w_out))
    ffn_norms = (l0_ffn_norm, l1_ffn_norm)
    peer_args = ((l0_peer_wq, l0_peer_keys, l0_peer_u, l0_peer_v),
                 (l1_peer_wq, l1_peer_keys, l1_peer_u, l1_peer_v))
    h = x
    for i in range(DEPTH):
        h = h + mixers[i % N_MIXERS](rms_norm(h, attn_norms[i]), *mixer_args[i])
        h = h + peer_ffn(rms_norm(h, ffn_norms[i]), *peer_args[i])
    return rms_norm(h, final_norm)
```

```cpp
#include <hip/hip_runtime.h>
#include <stdint.h>
#include <stdio.h>

#define DI __device__ __forceinline__
typedef unsigned short bf16_t;
typedef short bf16x8 __attribute__((ext_vector_type(8)));
typedef short s16x4 __attribute__((ext_vector_type(4)));
typedef float f32x4 __attribute__((ext_vector_type(4)));
typedef float f32x16 __attribute__((ext_vector_type(16)));
typedef unsigned u32x4 __attribute__((ext_vector_type(4)));
typedef unsigned u32x2 __attribute__((ext_vector_type(2)));

constexpr int DM = 1024, BATCH = 2, SEQ = 16384, NTOK = BATCH * SEQ;
constexpr int NSA_N = 2608, NSA_NP = 2816, FOX_N = 3088, FOX_NP = 3328;
constexpr float LOG2E = 1.4426950408889634f;
#define NEGINF (-__builtin_inff())

#define XB_TMO      128
#define XB_XCNT(j)  (256  + 64 * (j))
#define XB_XSUB(j)  (1280 + 64 * (j))
#define XB_XGEN(j)  (2304 + 64 * (j))
#define XB_TOP      3328
#define XB_TOPGEN   3392
#define XCD_BAR_WORDS 3456
#define XB_SPIN_CAP (1u << 18)
#define LAS __attribute__((address_space(3)))

__device__ __forceinline__ unsigned xb_ld(unsigned* p)              { return __hip_atomic_load(p, __ATOMIC_RELAXED, __HIP_MEMORY_SCOPE_AGENT); }
__device__ __forceinline__ unsigned xb_add(unsigned* p, unsigned v) { return __hip_atomic_fetch_add(p, v, __ATOMIC_RELAXED, __HIP_MEMORY_SCOPE_AGENT); }
__device__ __forceinline__ unsigned xb_xcc_id() { return (unsigned)__builtin_amdgcn_s_getreg((3 << 11) | 20) & 0xFu; }
#define XB_SPIN(cond, bar) do { unsigned _sp = 0; while (cond) { __builtin_amdgcn_s_sleep(1); \
    if ((++_sp & 255u) == 0u) { if (xb_ld(&(bar)[XB_TMO])) break; if (_sp > XB_SPIN_CAP) { atomicAdd(&(bar)[XB_TMO], 1u); break; } } } } while (0)

struct XcdBarrier { unsigned* bar; unsigned x; volatile LAS unsigned* st; };

__device__ __forceinline__ XcdBarrier xcd_barrier_post(unsigned* bar, volatile LAS unsigned* st) {
    XcdBarrier b; b.bar = bar; b.x = xb_xcc_id(); b.st = st;
    if (threadIdx.x == 0) (void)xb_add(&bar[XB_XCNT(b.x)], 1u);
    return b;
}
__device__ __forceinline__ void xcd_barrier_complete(unsigned* bar, unsigned x, unsigned& nloc, unsigned& nx) {
    const unsigned G = gridDim.x * gridDim.y * gridDim.z;
    unsigned sum, cnt, mine, sp = 0u;
    for (;;) {
        sum = 0u; cnt = 0u; mine = 0u;
#pragma unroll
        for (unsigned j = 0; j < 16; ++j) { const unsigned c = xb_ld(&bar[XB_XCNT(j)]); sum += c; cnt += (c > 0u) ? 1u : 0u; mine = (j == x) ? c : mine; }
        if (sum == G) break;
        __builtin_amdgcn_s_sleep(1);
        if ((++sp & 255u) == 0u) { if (xb_ld(&bar[XB_TMO])) break; if (sp > XB_SPIN_CAP) { atomicAdd(&bar[XB_TMO], 1u); break; } }
    }
    nloc = mine > 0u ? mine : 1u; nx = cnt > 0u ? cnt : 1u;
}
__device__ __forceinline__ void xcd_barrier(const XcdBarrier& b) {
    asm volatile("s_waitcnt vmcnt(0)" ::: "memory");
    __syncthreads();
    if (threadIdx.x == 0) {
        unsigned* bar = b.bar;
        __builtin_amdgcn_s_waitcnt(0);
        unsigned nloc = b.st[0], nx = b.st[1];
        if (nloc == 0u) { xcd_barrier_complete(bar, b.x, nloc, nx); b.st[0] = nloc; b.st[1] = nx; }
        const unsigned old = xb_add(&bar[XB_XSUB(b.x)], 1u);
        const unsigned gen = old / nloc;
        if (old + 1u == (gen + 1u) * nloc) {
            __builtin_amdgcn_fence(__ATOMIC_RELEASE, "agent");
            asm volatile("s_waitcnt vmcnt(0)" ::: "memory");
            const unsigned og = xb_add(&bar[XB_TOP], 1u);
            const unsigned tg = og / nx;
            if (og + 1u == (tg + 1u) * nx) xb_add(&bar[XB_TOPGEN], 1u);
            else XB_SPIN(xb_ld(&bar[XB_TOPGEN]) == tg, bar);
            __builtin_amdgcn_fence(__ATOMIC_ACQUIRE, "agent");
            xb_add(&bar[XB_XGEN(b.x)], 1u);
            asm volatile("s_waitcnt vmcnt(0)" ::: "memory");
        } else {
            XB_SPIN(xb_ld(&bar[XB_XGEN(b.x)]) == gen, bar);
            __builtin_amdgcn_fence(__ATOMIC_ACQUIRE, "agent");
            asm volatile("s_waitcnt vmcnt(0)" ::: "memory");
        }
    }
    __syncthreads();
}

struct Params {
    const float *x, *l0_attn_norm, *l0_w_in, *l0_pe_k, *l0_w1_k, *l0_w2_k, *l0_pe_v, *l0_w1_v, *l0_w2_v, *l0_w_out, *l0_ffn_norm, *l0_wq, *l0_keys, *l0_u, *l0_v;
    const float *l1_attn_norm, *l1_w_in, *l1_f_bias, *l1_w_out, *l1_ffn_norm, *l1_wq, *l1_keys, *l1_u, *l1_v, *final_norm;
    float* out;
    unsigned* bar; float2* rope;
    bf16_t *wt_in0, *wt_out0, *wq0b, *keys0b, *weff0, *wt_in1, *wt_out1, *wq1b, *keys1b, *weff1, *w1t, *w2t;
    float* b1;
    unsigned char *u8, *v8s; float* coef;
    bf16_t* xn; unsigned char* xq8;
    bf16_t *q0, *kcin, *vcin, *kslc, *vslcT, *kwin, *vwinT, *o0, *kcmp, *vcmpT, *hid;
    float* gates0; int* sel;
    float* scores; int* eidx; float* egate;
    bf16_t *q1, *k1, *v1T, *o1;
    float* cfox; unsigned* nrm;
};

DI float bf2f(bf16_t v) { return __uint_as_float((unsigned)v << 16); }
DI bf16_t f2bf(float f) { __bf16 b = (__bf16)f; return __builtin_bit_cast(bf16_t, b); }
typedef __bf16 bf16x2_t __attribute__((ext_vector_type(2)));
typedef float f32x2 __attribute__((ext_vector_type(2)));
DI unsigned pack2(float lo, float hi) { const f32x2 v = {lo, hi}; return __builtin_bit_cast(unsigned, __builtin_convertvector(v, bf16x2_t)); }
DI float bflo(unsigned w) { return __uint_as_float(w << 16); }
DI float bfhi(unsigned w) { return __uint_as_float(w & 0xffff0000u); }
DI float gelu_tanh(float x) {
    const float y = 0.7978845608028654f * (x + 0.044715f * x * x * x);
    const float e = __expf(2.0f * y);
    const float t = 1.0f - 2.0f / (e + 1.0f);
    return 0.5f * x * (1.0f + t);
}
DI unsigned ordf(float f) { const unsigned u = __float_as_uint(f); return u ^ ((u & 0x80000000u) ? 0xffffffffu : 0x80000000u); }
DI float unordf(unsigned o) { const unsigned u = o ^ ((o & 0x80000000u) ? 0x80000000u : 0xffffffffu); return __uint_as_float(u); }
#define MFMA16(a, b, c) __builtin_amdgcn_mfma_f32_16x16x32_bf16((a), (b), (c), 0, 0, 0)
#define MFMA32(a, b, c) __builtin_amdgcn_mfma_f32_32x32x16_bf16((a), (b), (c), 0, 0, 0)

DI float xhalf_max(float x) { const auto t = __builtin_amdgcn_permlane32_swap(__float_as_uint(x), __float_as_uint(x), false, false); return fmaxf(__uint_as_float(t[0]), __uint_as_float(t[1])); }
DI float xhalf_sum(float x) { const auto t = __builtin_amdgcn_permlane32_swap(__float_as_uint(x), __float_as_uint(x), false, false); return __uint_as_float(t[0]) + __uint_as_float(t[1]); }
DI float swap32_add(float x, float y) { const auto t = __builtin_amdgcn_permlane32_swap(__float_as_uint(x), __float_as_uint(y), false, false); return __uint_as_float(t[0]) + __uint_as_float(t[1]); }
DI float swap16_add(float x, float y) { const auto t = __builtin_amdgcn_permlane16_swap(__float_as_uint(x), __float_as_uint(y), false, false); return __uint_as_float(t[0]) + __uint_as_float(t[1]); }
DI float dpp_f(float x, int ctrl_unused) { return x; }
template <int CTRL> DI float dppf(float x) { return __builtin_bit_cast(float, __builtin_amdgcn_update_dpp(0, __builtin_bit_cast(int, x), CTRL, 0xF, 0xF, true)); }
DI float octet_sum(float x) { x += dppf<0xB1>(x); x += dppf<0x4E>(x); x += dppf<0x141>(x); return x; }
DI float xrow16_sum(float x) { const auto s_ = __builtin_amdgcn_permlane16_swap(__float_as_uint(x), __float_as_uint(x), false, false); return xhalf_sum(__uint_as_float(s_[0]) + __uint_as_float(s_[1])); }
DI float xrow16_max(float x) { const auto s = __builtin_amdgcn_permlane16_swap(__float_as_uint(x), __float_as_uint(x), false, false); return xhalf_max(fmaxf(__uint_as_float(s[0]), __uint_as_float(s[1]))); }
constexpr int GS = 72;
template <class Epi>
DI void gemm_tile(const bf16_t* __restrict__ A, int lda, const bf16_t* __restrict__ B, int ldb, int K, int m0, int n0, const Epi& epi, bf16_t* As, bf16_t* Bs) {
    const int tid = threadIdx.x, lane = tid & 63, wid = tid >> 6, wm = wid >> 1, wn = wid & 1, lr = lane & 15, lg = lane >> 4;
    f32x4 acc[4][4];
#pragma unroll
    for (int i = 0; i < 4; ++i)
#pragma unroll
        for (int j = 0; j < 4; ++j) acc[i][j] = (f32x4){0.f, 0.f, 0.f, 0.f};
    const int crow = tid >> 3, ckc = tid & 7;
    const bf16_t* ap = A + (size_t)(m0 + crow) * lda + ckc * 8;
    const bf16_t* bp = B + (size_t)(n0 + crow) * ldb + ckc * 8;
    u32x4 ra[4], rb[4];
#pragma unroll
    for (int i = 0; i < 4; ++i) { ra[i] = *(const u32x4*)(ap + (size_t)(32 * i) * lda); rb[i] = *(const u32x4*)(bp + (size_t)(32 * i) * ldb); }
    const int nk = K >> 6;
    for (int kt = 0; kt < nk; ++kt) {
        __syncthreads();
#pragma unroll
        for (int i = 0; i < 4; ++i) { *(u32x4*)(As + (crow + 32 * i) * GS + ckc * 8) = ra[i]; *(u32x4*)(Bs + (crow + 32 * i) * GS + ckc * 8) = rb[i]; }
        __syncthreads();
        if (kt + 1 < nk) {
            ap += 64; bp += 64;
#pragma unroll
            for (int i = 0; i < 4; ++i) { ra[i] = *(const u32x4*)(ap + (size_t)(32 * i) * lda); rb[i] = *(const u32x4*)(bp + (size_t)(32 * i) * ldb); }
        }
#pragma unroll
        for (int ks = 0; ks < 2; ++ks) {
            bf16x8 a[4], b[4];
#pragma unroll
            for (int i = 0; i < 4; ++i) {
                a[i] = *(const bf16x8*)(As + (wm * 64 + i * 16 + lr) * GS + ks * 32 + lg * 8);
                b[i] = *(const bf16x8*)(Bs + (wn * 64 + i * 16 + lr) * GS + ks * 32 + lg * 8);
            }
#pragma unroll
            for (int i = 0; i < 4; ++i)
#pragma unroll
                for (int j = 0; j < 4; ++j) acc[i][j] = MFMA16(a[i], b[j], acc[i][j]);
        }
    }
    epi(acc, m0 + wm * 64, n0 + wn * 64, lr, lg);
}

template <class Epi>
DI void gemm_tile_w(const bf16_t* __restrict__ A, int lda, const bf16_t* __restrict__ B, int ldb, int K, int m0, int n0, const Epi& epi, bf16_t* As, bf16_t* Bs) {
    const int tid = threadIdx.x, lane = tid & 63, wid = tid >> 6, wm = wid >> 1, wn = wid & 1, lr = lane & 15, lg = lane >> 4;
    f32x4 acc[2][4][4];
#pragma unroll
    for (int h = 0; h < 2; ++h)
#pragma unroll
        for (int i = 0; i < 4; ++i)
#pragma unroll
            for (int j = 0; j < 4; ++j) acc[h][i][j] = (f32x4){0.f, 0.f, 0.f, 0.f};
    const int crow = tid >> 3, ckc = tid & 7;
    const bf16_t* ap = A + (size_t)(m0 + crow) * lda + ckc * 8;
    const bf16_t* bp = B + (size_t)(n0 + crow) * ldb + ckc * 8;
    u32x4 ra[4], rb[8];
#pragma unroll
    for (int i = 0; i < 4; ++i) ra[i] = *(const u32x4*)(ap + (size_t)(32 * i) * lda);
#pragma unroll
    for (int i = 0; i < 8; ++i) rb[i] = *(const u32x4*)(bp + (size_t)(32 * i) * ldb);
    const int nk = K >> 6;
    for (int kt = 0; kt < nk; ++kt) {
        __syncthreads();
#pragma unroll
        for (int i = 0; i < 4; ++i) *(u32x4*)(As + (crow + 32 * i) * GS + ckc * 8) = ra[i];
#pragma unroll
        for (int i = 0; i < 8; ++i) *(u32x4*)(Bs + (crow + 32 * i) * GS + ckc * 8) = rb[i];
        __syncthreads();
        if (kt + 1 < nk) {
            ap += 64; bp += 64;
#pragma unroll
            for (int i = 0; i < 4; ++i) ra[i] = *(const u32x4*)(ap + (size_t)(32 * i) * lda);
#pragma unroll
            for (int i = 0; i < 8; ++i) rb[i] = *(const u32x4*)(bp + (size_t)(32 * i) * ldb);
        }
#pragma unroll
        for (int ks = 0; ks < 2; ++ks) {
            bf16x8 a[4];
#pragma unroll
            for (int i = 0; i < 4; ++i) a[i] = *(const bf16x8*)(As + (wm * 64 + i * 16 + lr) * GS + ks * 32 + lg * 8);
#pragma unroll
            for (int h = 0; h < 2; ++h) {
                bf16x8 b[4];
#pragma unroll
                for (int i = 0; i < 4; ++i) b[i] = *(const bf16x8*)(Bs + (wn * 128 + h * 64 + i * 16 + lr) * GS + ks * 32 + lg * 8);
#pragma unroll
                for (int i = 0; i < 4; ++i)
#pragma unroll
                    for (int j = 0; j < 4; ++j) acc[h][i][j] = MFMA16(a[i], b[j], acc[h][i][j]);
            }
        }
    }
    epi(acc[0], m0 + wm * 64, n0 + wn * 128, lr, lg);
    epi(acc[1], m0 + wm * 64, n0 + wn * 128 + 64, lr, lg);
}
DI bool gemm_order(int it, int ntn, int& tm, int& tn) {
    const int x = blockIdx.x & 7, rank = blockIdx.x >> 3, nrank = (gridDim.x - x + 7) >> 3;
    const int li = rank + it * nrank;
    if (li >= 32 * ntn) return false;
    const int mg = li / (ntn * 8), rem = li - mg * ntn * 8;
    tn = rem >> 3; tm = x * 32 + mg * 8 + (rem & 7);
    return true;
}

struct EpiIn0 {
    const Params* p;
    DI void operator()(f32x4 (&acc)[4][4], int mbase, int nbase, int lr, int lg) const {
        const int cidx = nbase >> 6;
        if (cidx >= 41) return;
        const int b = mbase >> 14;
        if (cidx == 40) {
#pragma unroll
            for (int mi = 0; mi < 4; ++mi)
#pragma unroll
                for (int ni = 0; ni < 3; ++ni)
#pragma unroll
                    for (int j = 0; j < 4; ++j) {
                        const int row = mbase + mi * 16 + lg * 4 + j;
                        p->gates0[(size_t)row * 48 + ni * 16 + lr] = 1.0f / (1.0f + __expf(-acc[mi][ni][j]));
                    }
            return;
        }
        int c6 = -1, g = 0;
        if (cidx >= 16) { c6 = (cidx - 16) >> 2; g = (cidx - 16) & 3; }
        const bool do_rope = (c6 < 0) || c6 == 0 || c6 == 2 || c6 == 4;
        if (do_rope) {
#pragma unroll
            for (int mi = 0; mi < 4; ++mi)
#pragma unroll
                for (int j = 0; j < 4; ++j) {
                    const int s = (mbase + mi * 16 + lg * 4 + j) & (SEQ - 1);
#pragma unroll
                    for (int ni = 0; ni < 2; ++ni) {
                        const float2 cs = p->rope[s * 32 + ni * 16 + lr];
                        const float x1 = acc[mi][ni][j], x2 = acc[mi][ni + 2][j];
                        acc[mi][ni][j] = x1 * cs.x - x2 * cs.y;
                        acc[mi][ni + 2][j] = x2 * cs.x + x1 * cs.y;
                    }
                }
        }
        if (c6 < 0) {
#pragma unroll
            for (int mi = 0; mi < 4; ++mi)
#pragma unroll
                for (int ni = 0; ni < 4; ++ni)
#pragma unroll
                    for (int j = 0; j < 4; ++j) {
                        const int row = mbase + mi * 16 + lg * 4 + j;
                        p->q0[(size_t)row * 1024 + cidx * 64 + ni * 16 + lr] = f2bf(acc[mi][ni][j] * (0.125f * LOG2E));
                    }
        } else if (c6 == 3 || c6 == 5) {
            const int bg = b * 4 + g;
#pragma unroll
            for (int mi = 0; mi < 4; ++mi)
#pragma unroll
                for (int ni = 0; ni < 4; ++ni) {
                    const int s0 = (mbase + mi * 16 + lg * 4) & (SEQ - 1), d = ni * 16 + lr;
                    u32x2 w; w.x = pack2(acc[mi][ni][0], acc[mi][ni][1]); w.y = pack2(acc[mi][ni][2], acc[mi][ni][3]);
                    bf16_t* dst = (c6 == 3) ? p->vslcT + ((size_t)(bg * 256 + (s0 >> 6)) * 64 + d) * 64 + (s0 & 63)
                                            : p->vwinT + ((size_t)bg * 64 + d) * SEQ + s0;
                    *(u32x2*)dst = w;
                }
        } else {
            bf16_t* base = (c6 == 0) ? p->kcin : (c6 == 1) ? p->vcin : (c6 == 2) ? p->kslc : p->kwin;
            const int bg = b * 4 + g;
#pragma unroll
            for (int mi = 0; mi < 4; ++mi)
#pragma unroll
                for (int ni = 0; ni < 4; ++ni)
#pragma unroll
                    for (int j = 0; j < 4; ++j) {
                        const int s = (mbase + mi * 16 + lg * 4 + j) & (SEQ - 1);
                        base[((size_t)bg * SEQ + s) * 64 + ni * 16 + lr] = f2bf(acc[mi][ni][j]);
                    }
        }
    }
};
struct EpiIn1 {
    const Params* p;
    DI void operator()(f32x4 (&acc)[4][4], int mbase, int nbase, int lr, int lg) const {
        const int cidx = nbase >> 6;
        if (cidx >= 49) return;
        const int b = mbase >> 14;
        if (cidx == 48) {
            const float fb = p->l1_f_bias[lr];
#pragma unroll
            for (int mi = 0; mi < 4; ++mi)
#pragma unroll
                for (int j = 0; j < 4; ++j) {
                    const int s = (mbase + mi * 16 + lg * 4 + j) & (SEQ - 1);
                    const float z = acc[mi][0][j] + fb;
                    p->cfox[((size_t)(b * 16 + lr)) * SEQ + s] = (fminf(z, 0.f) - log1pf(__expf(-fabsf(z)))) * LOG2E;
                }
            return;
        }
        if (cidx < 16) {
#pragma unroll
            for (int mi = 0; mi < 4; ++mi)
#pragma unroll
                for (int ni = 0; ni < 4; ++ni)
#pragma unroll
                    for (int j = 0; j < 4; ++j) {
                        const int row = mbase + mi * 16 + lg * 4 + j;
                        p->q1[(size_t)row * 1024 + cidx * 64 + ni * 16 + lr] = f2bf(acc[mi][ni][j] * (0.125f * LOG2E));
                    }
        } else if (cidx < 32) {
            const int bh = b * 16 + (cidx - 16);
#pragma unroll
            for (int mi = 0; mi < 4; ++mi)
#pragma unroll
                for (int ni = 0; ni < 4; ++ni)
#pragma unroll
                    for (int j = 0; j < 4; ++j) {
                        const int s = (mbase + mi * 16 + lg * 4 + j) & (SEQ - 1);
                        p->k1[((size_t)bh * SEQ + s) * 64 + ni * 16 + lr] = f2bf(acc[mi][ni][j]);
                    }
        } else {
            const int bh = b * 16 + (cidx - 32);
#pragma unroll
            for (int mi = 0; mi < 4; ++mi)
#pragma unroll
                for (int ni = 0; ni < 4; ++ni) {
                    const int s0 = (mbase + mi * 16 + lg * 4) & (SEQ - 1), d = ni * 16 + lr;
                    u32x2 w; w.x = pack2(acc[mi][ni][0], acc[mi][ni][1]); w.y = pack2(acc[mi][ni][2], acc[mi][ni][3]);
                    *(u32x2*)(p->v1T + ((size_t)bh * 64 + d) * SEQ + s0) = w;
                }
        }
    }
};
struct EpiResid {
    const float* res; float* out;
    DI void operator()(f32x4 (&acc)[4][4], int mbase, int nbase, int lr, int lg) const {
#pragma unroll
        for (int mi = 0; mi < 4; ++mi)
#pragma unroll
            for (int ni = 0; ni < 4; ++ni)
#pragma unroll
                for (int j = 0; j < 4; ++j) {
                    const size_t o = (size_t)(mbase + mi * 16 + lg * 4 + j) * 1024 + nbase + ni * 16 + lr;
                    out[o] = res[o] + acc[mi][ni][j];
                }
    }
};
struct EpiF32 {
    float* out; int ld;
    DI void operator()(f32x4 (&acc)[4][4], int mbase, int nbase, int lr, int lg) const {
#pragma unroll
        for (int mi = 0; mi < 4; ++mi)
#pragma unroll
            for (int ni = 0; ni < 4; ++ni)
#pragma unroll
                for (int j = 0; j < 4; ++j) out[(size_t)(mbase + mi * 16 + lg * 4 + j) * ld + nbase + ni * 16 + lr] = acc[mi][ni][j];
    }
};
struct EpiBf16 {
    bf16_t* out; int ld;
    DI void operator()(f32x4 (&acc)[4][4], int mbase, int nbase, int lr, int lg) const {
#pragma unroll
        for (int mi = 0; mi < 4; ++mi)
#pragma unroll
            for (int ni = 0; ni < 4; ++ni)
#pragma unroll
                for (int j = 0; j < 4; ++j) out[(size_t)(mbase + mi * 16 + lg * 4 + j) * ld + nbase + ni * 16 + lr] = f2bf(acc[mi][ni][j]);
    }
};
struct EpiCmp1 {
    bf16_t* out; const float* bias;
    DI void operator()(f32x4 (&acc)[4][4], int mbase, int nbase, int lr, int lg) const {
#pragma unroll
        for (int ni = 0; ni < 4; ++ni) {
            float bv = 0.f;
#pragma unroll
            for (int ksl = 0; ksl < 16; ++ksl) bv += bias[ksl * 1024 + nbase + ni * 16 + lr];
#pragma unroll
            for (int mi = 0; mi < 4; ++mi)
#pragma unroll
                for (int j = 0; j < 4; ++j) out[(size_t)(mbase + mi * 16 + lg * 4 + j) * 128 + nbase + ni * 16 + lr] = f2bf(gelu_tanh(acc[mi][ni][j] + bv));
        }
    }
};
struct EpiCmp2 {
    bf16_t* kc; bf16_t* vt; int kv;
    DI void operator()(f32x4 (&acc)[4][4], int mbase, int nbase, int lr, int lg) const {
        if (nbase >= 64) return;
#pragma unroll
        for (int mi = 0; mi < 4; ++mi)
#pragma unroll
            for (int ni = 0; ni < 4; ++ni) {
                const int c0 = mbase + mi * 16 + lg * 4, d = ni * 16 + lr;
                float v[4];
#pragma unroll
                for (int j = 0; j < 4; ++j) v[j] = (c0 + j < 1023) ? acc[mi][ni][j] : 0.f;
                if (kv == 0) {
#pragma unroll
                    for (int j = 0; j < 4; ++j) kc[(size_t)(c0 + j) * 64 + d] = f2bf(v[j]);
                } else {
                    u32x2 w; w.x = pack2(v[0], v[1]); w.y = pack2(v[2], v[3]);
                    *(u32x2*)(vt + (size_t)d * 1024 + c0) = w;
                }
            }
    }
};

DI void transpose_cvt(const float* __restrict__ in, int K, int N, int Npad, bf16_t* __restrict__ out, int gtid, int gsz) {
    const int total = Npad * (K >> 3);
    for (int idx = gtid; idx < total; idx += gsz) {
        const int n = idx % Npad, k8 = idx / Npad;
        u32x4 w = (u32x4){0u, 0u, 0u, 0u};
        if (n < N) {
            float v[8];
#pragma unroll
            for (int i = 0; i < 8; ++i) v[i] = in[(size_t)(k8 * 8 + i) * N + n];
            w.x = pack2(v[0], v[1]); w.y = pack2(v[2], v[3]); w.z = pack2(v[4], v[5]); w.w = pack2(v[6], v[7]);
        }
        *(u32x4*)(out + (size_t)n * K + k8 * 8) = w;
    }
}
DI void convert_bf16(const float* __restrict__ in, bf16_t* __restrict__ out, size_t n, int gtid, int gsz) {
    const size_t n8 = n >> 3;
    for (size_t i = gtid; i < n8; i += gsz) {
        const f32x4 a = *(const f32x4*)(in + i * 8), b = *(const f32x4*)(in + i * 8 + 4);
        u32x4 w; w.x = pack2(a[0], a[1]); w.y = pack2(a[2], a[3]); w.z = pack2(b[0], b[1]); w.w = pack2(b[2], b[3]);
        *(u32x4*)(out + i * 8) = w;
    }
}
constexpr float FP8_SCALE = 256.0f, FP8_INV = 1.0f / 256.0f;
DI unsigned pack4_fp8(float a, float b, float c, float d) {
    int w = 0;
    w = __builtin_amdgcn_cvt_pk_fp8_f32(a, b, w, false);
    w = __builtin_amdgcn_cvt_pk_fp8_f32(c, d, w, true);
    return (unsigned)w;
}
constexpr float U8_SCALE = 512.0f, X8_SCALE = 16.0f;
DI unsigned pack4_i8(float a, float b, float c, float d, float scale) {
    int v0 = (int)__builtin_rintf(a * scale), v1 = (int)__builtin_rintf(b * scale), v2 = (int)__builtin_rintf(c * scale), v3 = (int)__builtin_rintf(d * scale);
    v0 = v0 < -127 ? -127 : (v0 > 127 ? 127 : v0); v1 = v1 < -127 ? -127 : (v1 > 127 ? 127 : v1);
    v2 = v2 < -127 ? -127 : (v2 > 127 ? 127 : v2); v3 = v3 < -127 ? -127 : (v3 > 127 ? 127 : v3);
    return (unsigned)(v0 & 255) | ((unsigned)(v1 & 255) << 8) | ((unsigned)(v2 & 255) << 16) | ((unsigned)v3 << 24);
}
DI void convert_tables_fp8(const float* __restrict__ u, const float* __restrict__ v, unsigned char* __restrict__ u8, unsigned char* __restrict__ v8s, int gtid, int gsz) {
    for (int idx = gtid; idx < 16384 * 64; idx += gsz) {
        const int e = idx >> 6, c = idx & 63;
        const float* up = u + (size_t)e * 1024 + c * 16;
        const float* vp = v + (size_t)e * 1024 + c * 16;
        u32x4 wu, wv;
#pragma unroll
        for (int q = 0; q < 4; ++q) {
            const f32x4 a = *(const f32x4*)(up + 4 * q), b = *(const f32x4*)(vp + 4 * q) * FP8_SCALE;
            wu[q] = pack4_i8(a[0], a[1], a[2], a[3], U8_SCALE); wv[q] = pack4_fp8(b[0], b[1], b[2], b[3]);
        }
        *(u32x4*)(u8 + (size_t)e * 1024 + c * 16) = wu;
        *(u32x4*)(v8s + ((size_t)(c >> 3) * 16384 + e) * 128 + (c & 7) * 16) = wv;
    }
}
DI void rmsnorm_rows(const float* in, const float* gain, bf16_t* outb, float* outf) {
    const int lane = threadIdx.x & 63, gw = (blockIdx.x * blockDim.x + threadIdx.x) >> 6, nw = (gridDim.x * blockDim.x) >> 6;
    for (int row = gw; row < NTOK; row += nw) {
        const float* xr = in + (size_t)row * 1024;
        f32x4 v[4]; float ss = 0.f;
#pragma unroll
        for (int i = 0; i < 4; ++i) { v[i] = *(const f32x4*)(xr + i * 256 + lane * 4); ss += v[i][0] * v[i][0] + v[i][1] * v[i][1] + v[i][2] * v[i][2] + v[i][3] * v[i][3]; }
#pragma unroll
        for (int off = 32; off >= 1; off >>= 1) ss += __shfl_xor(ss, off);
        const float rs = rsqrtf(ss * (1.0f / 1024.0f) + 1e-6f);
#pragma unroll
        for (int i = 0; i < 4; ++i) {
            const f32x4 g = *(const f32x4*)(gain + i * 256 + lane * 4);
            const f32x4 y = v[i] * rs * g;
            if (outb) { u32x2 w; w.x = pack2(y[0], y[1]); w.y = pack2(y[2], y[3]); *(u32x2*)(outb + (size_t)row * 1024 + i * 256 + lane * 4) = w; }
            else *(f32x4*)(outf + (size_t)row * 1024 + i * 256 + lane * 4) = y;
        }
    }
}

DI void rmsnorm_rows_q8(const float* in, const float* gain, bf16_t* outb, unsigned char* out8) {
    const int lane = threadIdx.x & 63, gw = (blockIdx.x * blockDim.x + threadIdx.x) >> 6, nw = (gridDim.x * blockDim.x) >> 6;
    for (int row = gw; row < NTOK; row += nw) {
        const float* xr = in + (size_t)row * 1024;
        f32x4 v[4]; float ss = 0.f;
#pragma unroll
        for (int i = 0; i < 4; ++i) { v[i] = *(const f32x4*)(xr + i * 256 + lane * 4); ss += v[i][0] * v[i][0] + v[i][1] * v[i][1] + v[i][2] * v[i][2] + v[i][3] * v[i][3]; }
#pragma unroll
        for (int off = 32; off >= 1; off >>= 1) ss += __shfl_xor(ss, off);
        const float rs = rsqrtf(ss * (1.0f / 1024.0f) + 1e-6f);
#pragma unroll
        for (int i = 0; i < 4; ++i) {
            const f32x4 g = *(const f32x4*)(gain + i * 256 + lane * 4);
            const f32x4 y = v[i] * rs * g;
            u32x2 w; w.x = pack2(y[0], y[1]); w.y = pack2(y[2], y[3]);
            *(u32x2*)(outb + (size_t)row * 1024 + i * 256 + lane * 4) = w;
            *(unsigned*)(out8 + (size_t)row * 1024 + i * 256 + lane * 4) = pack4_i8(y[0], y[1], y[2], y[3], X8_SCALE);
        }
    }
}
template <int MODE>
DI void rmsnorm_pipe(const float* in, const float* gain, bf16_t* outb, float* outf, unsigned char* out8) {
    const int lane = threadIdx.x & 63, gw = (blockIdx.x * blockDim.x + threadIdx.x) >> 6, nw = (gridDim.x * blockDim.x) >> 6;
    f32x4 g[4];
#pragma unroll
    for (int i = 0; i < 4; ++i) g[i] = *(const f32x4*)(gain + i * 256 + lane * 4);
    int row = gw;
    f32x4 nv[4];
#pragma unroll
    for (int i = 0; i < 4; ++i) nv[i] = (f32x4){0.f, 0.f, 0.f, 0.f};
    if (row < NTOK) {
#pragma unroll
        for (int i = 0; i < 4; ++i) nv[i] = *(const f32x4*)(in + (size_t)row * 1024 + i * 256 + lane * 4);
    }
    for (; row < NTOK; row += nw) {
        f32x4 v[4];
#pragma unroll
        for (int i = 0; i < 4; ++i) v[i] = nv[i];
        if (row + nw < NTOK) {
#pragma unroll
            for (int i = 0; i < 4; ++i) nv[i] = *(const f32x4*)(in + (size_t)(row + nw) * 1024 + i * 256 + lane * 4);
        }
        float ss = 0.f;
#pragma unroll
        for (int i = 0; i < 4; ++i) ss += v[i][0] * v[i][0] + v[i][1] * v[i][1] + v[i][2] * v[i][2] + v[i][3] * v[i][3];
        ss = octet_sum(ss);
        ss = xrow16_sum(dppf<0x128>(ss) + ss);
        const float rs = rsqrtf(ss * (1.0f / 1024.0f) + 1e-6f);
#pragma unroll
        for (int i = 0; i < 4; ++i) {
            const f32x4 y = v[i] * rs * g[i];
            if (MODE == 2) *(f32x4*)(outf + (size_t)row * 1024 + i * 256 + lane * 4) = y;
            else { u32x2 w; w.x = pack2(y[0], y[1]); w.y = pack2(y[2], y[3]); *(u32x2*)(outb + (size_t)row * 1024 + i * 256 + lane * 4) = w; }
            if (MODE == 1) *(unsigned*)(out8 + (size_t)row * 1024 + i * 256 + lane * 4) = pack4_i8(y[0], y[1], y[2], y[3], X8_SCALE);
        }
    }
}
DI void phase_prologue(const Params& p) {
    const int gtid = blockIdx.x * blockDim.x + threadIdx.x, gsz = gridDim.x * blockDim.x;
    for (int idx = gtid; idx < SEQ * 32; idx += gsz) {
        const int s = idx >> 5, i = idx & 31;
        const float inv = powf(10000.0f, -(float)i / 32.0f);
        const float ang = (float)s * inv;
        float sn, cs; sincosf(ang, &sn, &cs);
        p.rope[idx] = make_float2(cs, sn);
    }
    transpose_cvt(p.l0_w_in, 1024, NSA_N, NSA_NP, p.wt_in0, gtid, gsz);
    transpose_cvt(p.l0_w_out, 1024, 1024, 1024, p.wt_out0, gtid, gsz);
    transpose_cvt(p.l1_w_in, 1024, FOX_N, FOX_NP, p.wt_in1, gtid, gsz);
    transpose_cvt(p.l1_w_out, 1024, 1024, 1024, p.wt_out1, gtid, gsz);
    for (int kv = 0; kv < 2; ++kv)
        for (int g = 0; g < 4; ++g) {
            transpose_cvt((kv ? p.l0_w1_v : p.l0_w1_k) + (size_t)g * 2048 * 128, 2048, 128, 128, p.w1t + (size_t)(kv * 4 + g) * 128 * 2048, gtid, gsz);
            transpose_cvt((kv ? p.l0_w2_v : p.l0_w2_k) + (size_t)g * 128 * 64, 128, 64, 128, p.w2t + (size_t)(kv * 4 + g) * 128 * 128, gtid, gsz);
        }
    convert_bf16(p.l0_wq, p.wq0b, (size_t)1024 * 2048, gtid, gsz);
    convert_bf16(p.l1_wq, p.wq1b, (size_t)1024 * 2048, gtid, gsz);
    convert_bf16(p.l0_keys, p.keys0b, (size_t)16 * 128 * 128, gtid, gsz);
    convert_bf16(p.l1_keys, p.keys1b, (size_t)16 * 128 * 128, gtid, gsz);
    convert_tables_fp8(p.l0_u, p.l0_v, p.u8, p.v8s, gtid, gsz);
    {
        const int lane = threadIdx.x & 63, gw = gtid >> 6, nw = gsz >> 6;
        for (int item = gw; item < 16 * 16; item += nw) {
            const int out = item >> 4, ksl = item & 15, kv = out >> 3, g = (out >> 1) & 3, h = (out & 1) * 64 + lane;
            const float* pe = (kv ? p.l0_pe_v : p.l0_pe_k) + g * 2048 + ksl * 128;
            const float* w1 = (kv ? p.l0_w1_v : p.l0_w1_k) + (size_t)g * 2048 * 128 + (size_t)ksl * 128 * 128 + h;
            float s0 = 0.f, s1 = 0.f, s2 = 0.f, s3 = 0.f;
            for (int kk = 0; kk < 128; kk += 4) {
                s0 += pe[kk] * w1[(size_t)kk * 128]; s1 += pe[kk + 1] * w1[(size_t)(kk + 1) * 128];
                s2 += pe[kk + 2] * w1[(size_t)(kk + 2) * 128]; s3 += pe[kk + 3] * w1[(size_t)(kk + 3) * 128];
            }
            p.b1[ksl * 1024 + (kv * 4 + g) * 128 + h] = (s0 + s1) + (s2 + s3);
        }
    }
    rmsnorm_pipe<0>(p.x, p.l0_attn_norm, p.xn, nullptr, nullptr);
}

DI void phase_gemm_in0(const Params& p, char* smem) {
    bf16_t* As = (bf16_t*)smem; bf16_t* Bs = As + 128 * GS;
    EpiIn0 e0{&p};
    { int tm, tn; for (int it = 0; gemm_order(it, 10, tm, tn); ++it) gemm_tile_w(p.xn, 1024, p.wt_in0, 1024, 1024, tm * 128, tn * 256, e0, As, Bs); }
    for (int t = blockIdx.x; t < NTOK / 128; t += gridDim.x) gemm_tile(p.xn, 1024, p.wt_in0, 1024, 1024, t * 128, 2560, e0, As, Bs);
    for (int t = blockIdx.x; t < 256; t += gridDim.x) {
        const int layer = t >> 7, hp = (t >> 3) & 15, nt = t & 7;
        EpiBf16 e{(layer ? p.weff1 : p.weff0) + (size_t)hp * 128 * 1024, 1024};
        gemm_tile((layer ? p.keys1b : p.keys0b) + (size_t)hp * 16384, 128, (layer ? p.wq1b : p.wq0b) + hp * 128, 2048, 128, 0, nt * 128, e, As, Bs);
    }
}
DI void phase_gemm_in1(const Params& p, char* smem) {
    bf16_t* As = (bf16_t*)smem; bf16_t* Bs = As + 128 * GS;
    EpiIn1 e1{&p};
    int tm, tn; for (int it = 0; gemm_order(it, 12, tm, tn); ++it) gemm_tile_w(p.xn, 1024, p.wt_in1, 1024, 1024, tm * 128, tn * 256, e1, As, Bs);
    for (int t = blockIdx.x; t < NTOK / 128; t += gridDim.x) gemm_tile(p.xn, 1024, p.wt_in1, 1024, 1024, t * 128, 3072, e1, As, Bs);
}
DI void phase_gemm_out(const bf16_t* o, const bf16_t* wt, const float* res, float* out, char* smem) {
    bf16_t* As = (bf16_t*)smem; bf16_t* Bs = As + 128 * GS;
    EpiResid e{res, out};
    int tm, tn; for (int it = 0; gemm_order(it, 4, tm, tn); ++it) gemm_tile_w(o, 1024, wt, 1024, 1024, tm * 128, tn * 256, e, As, Bs);
}
DI void phase_gemm_scores(const Params& p, const bf16_t* weff, char* smem) {
    bf16_t* As = (bf16_t*)smem; bf16_t* Bs = As + 128 * GS;
    EpiF32 e{p.scores, 2048};
    int tm, tn; for (int it = 0; gemm_order(it, 8, tm, tn); ++it) gemm_tile_w(p.xn, 1024, weff, 1024, 1024, tm * 128, tn * 256, e, As, Bs);
}
DI void phase_cmp1(const Params& p, char* smem) {
    bf16_t* As = (bf16_t*)smem; bf16_t* Bs = As + 128 * GS;
    for (int t = blockIdx.x; t < 128; t += gridDim.x) {
        const int q = t >> 3, mt = t & 7, kv = q >> 3, bg = q & 7, g = bg & 3;
        EpiCmp1 e{p.hid + (size_t)q * 1024 * 128, p.b1 + (kv * 4 + g) * 128};
        gemm_tile((kv ? p.vcin : p.kcin) + (size_t)bg * SEQ * 64, 1024, p.w1t + (size_t)(kv * 4 + g) * 128 * 2048, 2048, 2048, mt * 128, 0, e, As, Bs);
    }
}
DI void phase_cmp2(const Params& p, char* smem) {
    bf16_t* As = (bf16_t*)smem; bf16_t* Bs = As + 128 * GS;
    for (int t = blockIdx.x; t < 128; t += gridDim.x) {
        const int q = t >> 3, mt = t & 7, kv = q >> 3, bg = q & 7, g = bg & 3;
        EpiCmp2 e{p.kcmp + (size_t)bg * 1024 * 64, p.vcmpT + (size_t)bg * 64 * 1024, kv};
        gemm_tile(p.hid + (size_t)q * 1024 * 128, 128, p.w2t + (size_t)(kv * 4 + g) * 128 * 128, 128, 128, mt * 128, 0, e, As, Bs);
    }
}

constexpr int KS = 72;
DI int crow16(int reg, int hh) { return (reg & 3) + 8 * (reg >> 2) + 4 * hh; }
DI void tile_ld(const bf16_t* __restrict__ g, size_t row_stride, u32x4 (&r)[2]) {
#pragma unroll
    for (int i = 0; i < 2; ++i) { const int id = threadIdx.x + 256 * i; r[i] = *(const u32x4*)(g + (size_t)(id >> 3) * row_stride + (id & 7) * 8); }
}
DI void tile_st(bf16_t* l, const u32x4 (&r)[2]) {
#pragma unroll
    for (int i = 0; i < 2; ++i) { const int id = threadIdx.x + 256 * i; *(u32x4*)(l + (id >> 3) * KS + (id & 7) * 8) = r[i]; }
}
DI void qk_tile(const bf16_t* Ks, const bf16x8 (&qf)[4], f32x16 (&S)[2], int l31, int hh) {
    bf16x8 a[2][4];
#pragma unroll
    for (int kb = 0; kb < 2; ++kb)
#pragma unroll
        for (int ks = 0; ks < 4; ++ks) a[kb][ks] = *(const bf16x8*)(Ks + (32 * kb + l31) * KS + 16 * ks + 8 * hh);
#pragma unroll
    for (int kb = 0; kb < 2; ++kb) {
#pragma unroll
        for (int i = 0; i < 16; ++i) S[kb][i] = 0.f;
#pragma unroll
        for (int ks = 0; ks < 4; ++ks) S[kb] = MFMA32(a[kb][ks], qf[ks], S[kb]);
    }
}
DI void pv_tile(const bf16_t* Vs, const f32x16 (&P)[2], f32x16 (&O)[2], int l31, int hh) {
#pragma unroll
    for (int kb = 0; kb < 2; ++kb) {
        s16x4 lo[2][2], hi[2][2];
#pragma unroll
        for (int s = 0; s < 2; ++s)
#pragma unroll
            for (int db = 0; db < 2; ++db) {
                const bf16_t* vp = Vs + (32 * db + l31) * KS + 32 * kb + 16 * s + 4 * hh;
                lo[s][db] = *(const s16x4*)vp; hi[s][db] = *(const s16x4*)(vp + 8);
            }
#pragma unroll
        for (int s = 0; s < 2; ++s) {
            u32x4 pw;
            pw.x = pack2(P[kb][8 * s + 0], P[kb][8 * s + 1]); pw.y = pack2(P[kb][8 * s + 2], P[kb][8 * s + 3]);
            pw.z = pack2(P[kb][8 * s + 4], P[kb][8 * s + 5]); pw.w = pack2(P[kb][8 * s + 6], P[kb][8 * s + 7]);
            const bf16x8 pf = __builtin_bit_cast(bf16x8, pw);
#pragma unroll
            for (int db = 0; db < 2; ++db) {
                const bf16x8 a = __builtin_shufflevector(lo[s][db], hi[s][db], 0, 1, 2, 3, 4, 5, 6, 7);
                O[db] = MFMA32(a, pf, O[db]);
            }
        }
    }
}
DI void softmax_update(f32x16 (&S)[2], f32x16 (&O)[2], float& m, float& l) {
    float mx = NEGINF;
#pragma unroll
    for (int kb = 0; kb < 2; ++kb)
#pragma unroll
        for (int i = 0; i < 16; ++i) mx = fmaxf(mx, S[kb][i]);
    mx = fmaxf(mx, __shfl_xor(mx, 32));
    const float mnew = fmaxf(m, mx);
    const float msafe = (mnew == NEGINF) ? 0.f : mnew;
    const float alpha = __builtin_amdgcn_exp2f(m - msafe);
    float rs = 0.f;
#pragma unroll
    for (int kb = 0; kb < 2; ++kb)
#pragma unroll
        for (int i = 0; i < 16; ++i) { const float pv = __builtin_amdgcn_exp2f(S[kb][i] - msafe); S[kb][i] = pv; rs += pv; }
    l = l * alpha + rs; m = mnew;
#pragma unroll
    for (int db = 0; db < 2; ++db)
#pragma unroll
        for (int i = 0; i < 16; ++i) O[db][i] *= alpha;
}

DI void softmax_update_lazy(f32x16 (&S)[2], f32x16 (&O)[2], float& m, float& l) {
    float mx = NEGINF;
#pragma unroll
    for (int kb = 0; kb < 2; ++kb)
#pragma unroll
        for (int i = 0; i < 16; ++i) mx = fmaxf(mx, S[kb][i]);
    mx = xhalf_max(mx);
    if (__any(mx > m + 8.0f)) {
        const float mnew = fmaxf(m, mx), ms = (mnew == NEGINF) ? 0.f : mnew;
        const float alpha = __builtin_amdgcn_exp2f(m - ms);
        l *= alpha; m = mnew;
#pragma unroll
        for (int db = 0; db < 2; ++db)
#pragma unroll
            for (int i = 0; i < 16; ++i) O[db][i] *= alpha;
    }
    const float msafe = (m == NEGINF) ? 0.f : m;
    float rs = 0.f;
#pragma unroll
    for (int kb = 0; kb < 2; ++kb)
#pragma unroll
        for (int i = 0; i < 16; ++i) { const float pv = __builtin_amdgcn_exp2f(S[kb][i] - msafe); S[kb][i] = pv; rs += pv; }
    l += rs;
}
DI void phase_fox(const Params& p, char* smem) {
    bf16_t* T2 = (bf16_t*)smem;
    float* cks = (float*)(T2 + 4 * 64 * KS); int* ktmin = (int*)(cks + 128);
    const int tid = threadIdx.x, lane = tid & 63, wid = tid >> 6, l31 = lane & 31, hh = lane >> 5;
    for (int u = blockIdx.x; u < 4096; u += gridDim.x) {
        const int qt = 127 - (u >> 5), bh = u & 31, b = bh >> 4, h = bh & 15;
        const int t0 = qt * 128, tw = t0 + 32 * wid, tq = tw + l31;
        const bf16_t* Kg = p.k1 + (size_t)bh * SEQ * 64;
        const bf16_t* Vg = p.v1T + (size_t)bh * 64 * SEQ;
        const float* cg = p.cfox + (size_t)bh * SEQ;
        const int ntile = 2 * qt + 2;
        __syncthreads();
        if (tid == 0) *ktmin = ntile - 1;
        __syncthreads();
        {
            const float bnd = 2.0f * sqrtf(__uint_as_float(p.nrm[bh * 2]) * __uint_as_float(p.nrm[bh * 2 + 1])) + 160.0f;
            if (tid < ntile && (cg[t0] - cg[64 * tid + 63]) >= -bnd) atomicMin(ktmin, tid);
        }
        __syncthreads();
        const int kt_start = *ktmin;
        bf16x8 qf[4];
#pragma unroll
        for (int ks = 0; ks < 4; ++ks) qf[ks] = *(const bf16x8*)(p.q1 + ((size_t)(b * SEQ + tq)) * 1024 + h * 64 + 16 * ks + 8 * hh);
        const float cq = cg[tq];
        f32x16 O[2];
#pragma unroll
        for (int db = 0; db < 2; ++db)
#pragma unroll
            for (int i = 0; i < 16; ++i) O[db][i] = 0.f;
        float m = NEGINF, l = 0.f;
        const int s_hi = qt, s_lo = kt_start >> 1;
        u32x4 rk[2][2], rv[2][2]; float rc = 0.f;
#pragma unroll
        for (int q = 0; q < 2; ++q) { tile_ld(Kg + (size_t)(2 * s_hi + q) * 64 * 64, 64, rk[q]); tile_ld(Vg + (2 * s_hi + q) * 64, SEQ, rv[q]); }
        if (tid < 128) rc = cg[2 * s_hi * 64 + tid];
        for (int st = s_hi; st >= s_lo; --st) {
            __syncthreads();
#pragma unroll
            for (int q = 0; q < 2; ++q) { tile_st(T2 + q * 2 * 64 * KS, rk[q]); tile_st(T2 + q * 2 * 64 * KS + 64 * KS, rv[q]); }
            if (tid < 128) cks[tid] = rc;
            __syncthreads();
            if (st - 1 >= s_lo) {
#pragma unroll
                for (int q = 0; q < 2; ++q) { tile_ld(Kg + (size_t)(2 * (st - 1) + q) * 64 * 64, 64, rk[q]); tile_ld(Vg + (2 * (st - 1) + q) * 64, SEQ, rv[q]); }
                if (tid < 128) rc = cg[2 * (st - 1) * 64 + tid];
            }
#pragma unroll
            for (int qq = 0; qq < 2; ++qq) {
                const int q = 1 - qq, kt = 2 * st + q, k0 = kt * 64;
                if (kt < kt_start || k0 > tw + 31) continue;
                const bf16_t* Ks = T2 + q * 2 * 64 * KS; const bf16_t* Vs = Ks + 64 * KS;
                f32x16 S[2];
#pragma unroll
                for (int kb = 0; kb < 2; ++kb)
#pragma unroll
                    for (int g4 = 0; g4 < 4; ++g4) {
                        const f32x4 ck = *(const f32x4*)(cks + 64 * q + 32 * kb + 8 * g4 + 4 * hh);
#pragma unroll
                        for (int j = 0; j < 4; ++j) S[kb][4 * g4 + j] = cq - ck[j];
                    }
                {
                    bf16x8 a[2][4];
#pragma unroll
                    for (int kb = 0; kb < 2; ++kb)
#pragma unroll
                        for (int ks = 0; ks < 4; ++ks) a[kb][ks] = *(const bf16x8*)(Ks + (32 * kb + l31) * KS + 16 * ks + 8 * hh);
#pragma unroll
                    for (int kb = 0; kb < 2; ++kb)
#pragma unroll
                        for (int ks = 0; ks < 4; ++ks) S[kb] = MFMA32(a[kb][ks], qf[ks], S[kb]);
                }
                if (k0 + 63 > tw) {
#pragma unroll
                    for (int kb = 0; kb < 2; ++kb)
#pragma unroll
                        for (int i = 0; i < 16; ++i) { const int key = k0 + 32 * kb + crow16(i, hh); S[kb][i] = (key <= tq) ? S[kb][i] : NEGINF; }
                }
                softmax_update_lazy(S, O, m, l);
                pv_tile(Vs, S, O, l31, hh);
            }
        }
        l = xhalf_sum(l);
        const float inv = 1.0f / l;
        bf16_t* op = p.o1 + ((size_t)(b * SEQ + tq)) * 1024 + h * 64;
#pragma unroll
        for (int db = 0; db < 2; ++db)
#pragma unroll
            for (int g4 = 0; g4 < 4; ++g4) {
                u32x2 w; w.x = pack2(O[db][4 * g4] * inv, O[db][4 * g4 + 1] * inv); w.y = pack2(O[db][4 * g4 + 2] * inv, O[db][4 * g4 + 3] * inv);
                *(u32x2*)(op + 32 * db + 8 * g4 + 4 * hh) = w;
            }
    }
}

constexpr int IST = 257;
DI unsigned octet_max_u32(unsigned v) {
    v = max(v, (unsigned)__builtin_amdgcn_update_dpp(0, (int)v, 0xB1, 0xF, 0xF, true));
    v = max(v, (unsigned)__builtin_amdgcn_update_dpp(0, (int)v, 0x4E, 0xF, 0xF, true));
    v = max(v, (unsigned)__builtin_amdgcn_update_dpp(0, (int)v, 0x141, 0xF, 0xF, true));
    return v;
}
DI void phase_nsa_a(const Params& p, char* smem) {
    bf16_t* Ks = (bf16_t*)smem; bf16_t* Vs = Ks + 64 * KS; float* imp = (float*)(Vs + 64 * KS);
    const int tid = threadIdx.x, lane = tid & 63, wid = tid >> 6, l31 = lane & 31, hh = lane >> 5;
    for (int u = blockIdx.x; u < 4096; u += gridDim.x) {
        const int tile = 511 - (u >> 3), bg = u & 7, b = bg >> 2, g = bg & 3;
        const int hd = l31 & 3, ql8 = 8 * wid + (l31 >> 2);
        const int t0 = tile * 32, tq = t0 + ql8;
        const size_t tok = (size_t)b * SEQ + tq;
        bf16x8 qf[4];
#pragma unroll
        for (int ks = 0; ks < 4; ++ks) qf[ks] = *(const bf16x8*)(p.q0 + tok * 1024 + (g * 4 + hd) * 64 + 16 * ks + 8 * hh);
        const bf16_t* Kc = p.kcmp + (size_t)bg * 1024 * 64;
        const bf16_t* Vc = p.vcmpT + (size_t)bg * 64 * 1024;
        const int ntc = ((t0 >> 4) >> 6) + 1;
        const int call = (t0 - 31) >> 4;
        float m = NEGINF, l = 0.f;
        u32x4 rk[2], rv[2];
        tile_ld(Kc, 64, rk);
        for (int kt = 0; kt < ntc; ++kt) {
            __syncthreads();
            tile_st(Ks, rk);
            __syncthreads();
            if (kt + 1 < ntc) tile_ld(Kc + (size_t)(kt + 1) * 64 * 64, 64, rk);
            f32x16 S[2];
            qk_tile(Ks, qf, S, l31, hh);
            if (kt * 64 + 63 > call) {
#pragma unroll
                for (int kb = 0; kb < 2; ++kb)
#pragma unroll
                    for (int i = 0; i < 16; ++i) { const int c = kt * 64 + 32 * kb + crow16(i, hh); S[kb][i] = (16 * c + 31 <= tq) ? S[kb][i] : NEGINF; }
            }
            float mx = NEGINF;
#pragma unroll
            for (int kb = 0; kb < 2; ++kb)
#pragma unroll
                for (int i = 0; i < 16; ++i) mx = fmaxf(mx, S[kb][i]);
            mx = fmaxf(mx, __shfl_xor(mx, 32));
            if (__any(mx > m + 8.0f)) { const float mnew = fmaxf(m, mx), ms = (mnew == NEGINF) ? 0.f : mnew; l *= __builtin_amdgcn_exp2f(m - ms); m = mnew; }
            const float msafe = (m == NEGINF) ? 0.f : m;
            float rs = 0.f;
#pragma unroll
            for (int kb = 0; kb < 2; ++kb)
#pragma unroll
                for (int i = 0; i < 16; ++i) rs += __builtin_amdgcn_exp2f(S[kb][i] - msafe);
            l += rs;
        }
        l += __shfl_xor(l, 32);
        const float mfin = (m == NEGINF) ? 0.f : m, invl = (l > 0.f) ? 1.0f / l : 0.f;
        __syncthreads();
        f32x16 O[2];
#pragma unroll
        for (int db = 0; db < 2; ++db)
#pragma unroll
            for (int i = 0; i < 16; ++i) O[db][i] = 0.f;
        float carry = 0.f;
        tile_ld(Kc, 64, rk); tile_ld(Vc, 1024, rv);
        for (int kt = 0; kt < ntc; ++kt) {
            __syncthreads();
            tile_st(Ks, rk); tile_st(Vs, rv);
            __syncthreads();
            if (kt + 1 < ntc) { tile_ld(Kc + (size_t)(kt + 1) * 64 * 64, 64, rk); tile_ld(Vc + (kt + 1) * 64, 1024, rv); }
            f32x16 S[2];
            qk_tile(Ks, qf, S, l31, hh);
            if (kt * 64 + 63 > call) {
#pragma unroll
                for (int kb = 0; kb < 2; ++kb)
#pragma unroll
                    for (int i = 0; i < 16; ++i) { const int c = kt * 64 + 32 * kb + crow16(i, hh); S[kb][i] = (16 * c + 31 <= tq) ? S[kb][i] : NEGINF; }
            }
#pragma unroll
            for (int kb = 0; kb < 2; ++kb)
#pragma unroll
                for (int i = 0; i < 16; ++i) S[kb][i] = __builtin_amdgcn_exp2f(S[kb][i] - mfin) * invl;
            float A[2][4], P[2][4];
#pragma unroll
            for (int kb = 0; kb < 2; ++kb)
#pragma unroll
                for (int g4 = 0; g4 < 4; ++g4) {
                    float sp = 0.5f * S[kb][4 * g4 + 3];
                    float a = (S[kb][4 * g4] + S[kb][4 * g4 + 1]) + (S[kb][4 * g4 + 2] + sp);
                    a += __builtin_bit_cast(float, __builtin_amdgcn_update_dpp(0, __builtin_bit_cast(int, a), 0xB1, 0xF, 0xF, true));
                    a += __builtin_bit_cast(float, __builtin_amdgcn_update_dpp(0, __builtin_bit_cast(int, a), 0x4E, 0xF, 0xF, true));
                    sp += __builtin_bit_cast(float, __builtin_amdgcn_update_dpp(0, __builtin_bit_cast(int, sp), 0xB1, 0xF, 0xF, true));
                    sp += __builtin_bit_cast(float, __builtin_amdgcn_update_dpp(0, __builtin_bit_cast(int, sp), 0x4E, 0xF, 0xF, true));
                    const auto t = __builtin_amdgcn_permlane32_swap(__float_as_uint(sp), __float_as_uint(sp), false, false);
                    A[kb][g4] = a; P[kb][g4] = (__uint_as_float(t[0]) + __uint_as_float(t[1])) - sp;
                }
#pragma unroll
            for (int kb = 0; kb < 2; ++kb)
#pragma unroll
                for (int g4 = 0; g4 < 4; ++g4) {
                    const float prev = (g4 > 0) ? P[kb][g4 - 1] : (kb > 0 ? P[0][3] : carry);
                    const float v = A[kb][g4] + (hh ? P[kb][g4] : prev);
                    if (hd == 0) imp[ql8 * IST + 16 * kt + 8 * kb + 2 * g4 + hh] = v;
                }
            carry = P[1][3];
            pv_tile(Vs, S, O, l31, hh);
        }
        __syncthreads();
        {
            const int ql = lane >> 3, sub = lane & 7, q = 8 * wid + ql, cur = t0 >> 6, imax = cur >> 3;
            unsigned k[32];
#pragma unroll
            for (int i = 0; i < 32; ++i) {
                k[i] = 0u;
                if (i <= imax) {
                    const int j = sub + 8 * i;
                    const float v = imp[q * IST + j];
                    const bool forced = (j == 0) | (j == cur) | (j == cur - 1);
                    const float val = forced ? 1.0e4f : ((j <= cur) ? v : -1.0f);
                    k[i] = (ordf(val) & 0xffffff00u) | (unsigned)(255 - j);
                }
            }
            int s0 = 255, s1 = 255;
            for (int r = 0; r < 16; ++r) {
                unsigned best = 0u;
#pragma unroll
                for (int i = 0; i < 32; ++i) if (i <= imax) best = max(best, k[i]);
                best = octet_max_u32(best);
                const int jw = 255 - (int)(best & 255u);
                if (r == sub) s0 = jw;
                if (r == sub + 8) s1 = jw;
#pragma unroll
                for (int i = 0; i < 32; ++i) if (i <= imax) k[i] = (k[i] == best) ? 0u : k[i];
            }
            int* sp = p.sel + (((size_t)b * SEQ + t0 + q) * 4 + g) * 16;
            sp[sub] = s0; sp[8 + sub] = s1;
        }
        __syncthreads();
        float* ob = imp + (wid * 32 + l31) * 64;
        {
            const float gc = p.gates0[tok * 48 + g * 4 + hd];
#pragma unroll
            for (int db = 0; db < 2; ++db)
#pragma unroll
                for (int g4 = 0; g4 < 4; ++g4)
                    *(f32x4*)(ob + 32 * db + 8 * g4 + 4 * hh) = (f32x4){O[db][4 * g4] * gc, O[db][4 * g4 + 1] * gc, O[db][4 * g4 + 2] * gc, O[db][4 * g4 + 3] * gc};
        }
        const bf16_t* Kw = p.kwin + (size_t)bg * SEQ * 64;
        const bf16_t* Vw = p.vwinT + (size_t)bg * 64 * SEQ;
        const int lo = (t0 - 511) > 0 ? (t0 - 511) : 0;
        const int kt_lo = lo >> 6, kt_hi = (t0 + 31) >> 6;
#pragma unroll
        for (int db = 0; db < 2; ++db)
#pragma unroll
            for (int i = 0; i < 16; ++i) O[db][i] = 0.f;
        m = NEGINF; l = 0.f;
        tile_ld(Kw + (size_t)kt_hi * 64 * 64, 64, rk); tile_ld(Vw + kt_hi * 64, SEQ, rv);
        for (int kt = kt_hi; kt >= kt_lo; --kt) {
            __syncthreads();
            tile_st(Ks, rk); tile_st(Vs, rv);
            __syncthreads();
            if (kt - 1 >= kt_lo) { tile_ld(Kw + (size_t)(kt - 1) * 64 * 64, 64, rk); tile_ld(Vw + (kt - 1) * 64, SEQ, rv); }
            f32x16 S[2];
            qk_tile(Ks, qf, S, l31, hh);
            if (!(kt * 64 + 63 <= t0 && kt * 64 > t0 + 31 - 512)) {
#pragma unroll
                for (int kb = 0; kb < 2; ++kb)
#pragma unroll
                    for (int i = 0; i < 16; ++i) {
                        const int key = kt * 64 + 32 * kb + crow16(i, hh);
                        S[kb][i] = (key <= tq && key > tq - 512) ? S[kb][i] : NEGINF;
                    }
            }
            softmax_update_lazy(S, O, m, l);
            pv_tile(Vs, S, O, l31, hh);
        }
        l += __shfl_xor(l, 32);
        {
            const float gw = p.gates0[tok * 48 + 32 + g * 4 + hd] / l;
            bf16_t* op = p.o0 + tok * 1024 + (g * 4 + hd) * 64;
#pragma unroll
            for (int db = 0; db < 2; ++db)
#pragma unroll
                for (int g4 = 0; g4 < 4; ++g4) {
                    const f32x4 oc = *(const f32x4*)(ob + 32 * db + 8 * g4 + 4 * hh);
                    u32x2 w;
                    w.x = pack2(oc[0] + O[db][4 * g4] * gw, oc[1] + O[db][4 * g4 + 1] * gw);
                    w.y = pack2(oc[2] + O[db][4 * g4 + 2] * gw, oc[3] + O[db][4 * g4 + 3] * gw);
                    *(u32x2*)(op + 32 * db + 8 * g4 + 4 * hh) = w;
                }
        }
        __syncthreads();
    }
}

constexpr int NB_ST = 2;
constexpr int NB_TILE = 2 * 64 * KS;
constexpr int OST = 68;
constexpr int NSB_LDS = NB_ST * NB_TILE * 2 + 2048 + 256 + 1024 + 1024 + 256 * OST * 2;
DI int kth_bit4(unsigned mask, int k) {
    unsigned x = mask;
    x = (k >= 1) ? (x & (x - 1u)) : x;
    x = (k >= 2) ? (x & (x - 1u)) : x;
    x = (k >= 3) ? (x & (x - 1u)) : x;
    return __builtin_ctz(x ? x : mask);
}
DI void nsa_b_cgroup(const bf16_t* Ks, const bf16_t* Vs, float* Mst, float* Lst, bf16_t* Ost, const bf16x8 q0, const bf16x8 q1, int tloc, bool valid, bool masked, bool diag,
                     int r, int lr, int lg, const bf16x8 ones) {
    const int col = tloc * 4 + r;
    float m = Mst[col];
    f32x4 L; { const float lo = Lst[col]; L = (f32x4){lo, lo, lo, lo}; }
    u32x2 ow[4];
#pragma unroll
    for (int db = 0; db < 4; ++db) ow[db] = *(const u32x2*)(Ost + col * OST + 16 * db + 4 * lg);
    bf16x8 ka[4][2];
#pragma unroll
    for (int kb = 0; kb < 4; ++kb)
#pragma unroll
        for (int ks = 0; ks < 2; ++ks) ka[kb][ks] = *(const bf16x8*)(Ks + (16 * kb + lr) * KS + 32 * ks + 8 * lg);
    f32x4 S[4];
#pragma unroll
    for (int kb = 0; kb < 4; ++kb) {
        S[kb] = MFMA16(ka[kb][0], q0, ((f32x4){0.f, 0.f, 0.f, 0.f}));
        S[kb] = MFMA16(ka[kb][1], q1, S[kb]);
    }
    s16x4 vlo[2][4], vhi[2][4];
#pragma unroll
    for (int s2 = 0; s2 < 2; ++s2)
#pragma unroll
        for (int db = 0; db < 4; ++db) {
            const bf16_t* vq = Vs + (16 * db + lr) * KS + 32 * s2 + 4 * lg;
            vlo[s2][db] = *(const s16x4*)vq; vhi[s2][db] = *(const s16x4*)(vq + 16);
        }
    if (diag) {
#pragma unroll
        for (int kb = 0; kb < 4; ++kb)
#pragma unroll
            for (int jj = 0; jj < 4; ++jj) S[kb][jj] = ((16 * kb + 4 * lg + jj) <= tloc) ? S[kb][jj] : NEGINF;
    }
    float mx = fmaxf(fmaxf(fmaxf(S[0][0], S[0][1]), fmaxf(S[0][2], S[0][3])), fmaxf(fmaxf(S[1][0], S[1][1]), fmaxf(S[1][2], S[1][3])));
    mx = fmaxf(mx, fmaxf(fmaxf(fmaxf(S[2][0], S[2][1]), fmaxf(S[2][2], S[2][3])), fmaxf(fmaxf(S[3][0], S[3][1]), fmaxf(S[3][2], S[3][3]))));
    mx = xrow16_max(mx);
    float alpha = 1.f;
    if (__any(mx > m + 8.0f)) {
        const float mnew = fmaxf(m, mx), ms = (mnew == NEGINF) ? 0.f : mnew;
        alpha = __builtin_amdgcn_exp2f(m - ms);
        m = mnew;
    }
    const float msafe = (m == NEGINF) ? 0.f : m;
    L *= alpha;
    f32x4 O[4];
#pragma unroll
    for (int db = 0; db < 4; ++db) O[db] = (f32x4){bflo(ow[db].x) * alpha, bfhi(ow[db].x) * alpha, bflo(ow[db].y) * alpha, bfhi(ow[db].y) * alpha};
#pragma unroll
    for (int s2 = 0; s2 < 2; ++s2) {
        u32x4 pw;
        pw.x = pack2(__builtin_amdgcn_exp2f(S[2 * s2][0] - msafe), __builtin_amdgcn_exp2f(S[2 * s2][1] - msafe));
        pw.y = pack2(__builtin_amdgcn_exp2f(S[2 * s2][2] - msafe), __builtin_amdgcn_exp2f(S[2 * s2][3] - msafe));
        pw.z = pack2(__builtin_amdgcn_exp2f(S[2 * s2 + 1][0] - msafe), __builtin_amdgcn_exp2f(S[2 * s2 + 1][1] - msafe));
        pw.w = pack2(__builtin_amdgcn_exp2f(S[2 * s2 + 1][2] - msafe), __builtin_amdgcn_exp2f(S[2 * s2 + 1][3] - msafe));
        const bf16x8 pf = __builtin_bit_cast(bf16x8, pw);
        L = MFMA16(ones, pf, L);
#pragma unroll
        for (int db = 0; db < 4; ++db) {
            const bf16x8 a = __builtin_shufflevector(vlo[s2][db], vhi[s2][db], 0, 1, 2, 3, 4, 5, 6, 7);
            O[db] = MFMA16(a, pf, O[db]);
        }
    }
    if (valid) {
#pragma unroll
        for (int db = 0; db < 4; ++db) {
            u32x2 w; w.x = pack2(O[db][0], O[db][1]); w.y = pack2(O[db][2], O[db][3]);
            *(u32x2*)(Ost + col * OST + 16 * db + 4 * lg) = w;
        }
        if (lg == 0) { Mst[col] = m; Lst[col] = L[0]; }
    }
}
DI void phase_nsa_b(const Params& p, char* smem, const int dry_i) {
    const bool dry = dry_i != 0;
    bf16_t* Tl = (bf16_t*)smem;
    unsigned* tmask = (unsigned*)(Tl + NB_ST * NB_TILE);
    float* Mst = (float*)(tmask + 512 + 64);
    float* Lst = Mst + 256;
    bf16_t* Ost = (bf16_t*)(Lst + 256);
    const int tid = threadIdx.x, lane = tid & 63, wid = tid >> 6, lr = lane & 15, lg = lane >> 4, r = lr & 3, tsl = lr >> 2;
    const int grp = blockIdx.x & 7, rank = blockIdx.x >> 3, nrank = (gridDim.x - grp + 7) >> 3;
    const int bg = grp, b = bg >> 2, g = bg & 3;
    const short one = (short)0x3F80;
    const bf16x8 ones = {one, one, one, one, one, one, one, one};
    for (int round = 0; round * nrank < 256; ++round) {
        const int li = (round & 1) ? (round * nrank + (nrank - 1 - rank)) : (round * nrank + rank);
        if (li >= 256) continue;
        const int tile = 255 - li, t0 = tile * 64, cur = tile;
        __syncthreads();
        for (int i = tid; i < 512; i += 256) tmask[i] = 0u;
        Mst[tid] = NEGINF; Lst[tid] = 0.f;
        for (int i = tid; i < 256 * OST * 2 / 16; i += 256) ((u32x4*)Ost)[i] = (u32x4){0u, 0u, 0u, 0u};
        __syncthreads();
        {
            const int tk = tid >> 2;
            const int* sp = p.sel + (((size_t)b * SEQ + t0 + tk) * 4 + g) * 16 + 4 * (tid & 3);
#pragma unroll
            for (int i = 0; i < 4; ++i) atomicOr(&tmask[sp[i] * 2 + (tk >> 5)], 1u << (tk & 31));
        }
        const bf16_t* Kg = p.kslc + (size_t)bg * SEQ * 64;
        const bf16_t* Vg = p.vslcT + (size_t)bg * 256 * 4096;
        const bf16_t* qbase = p.q0 + ((size_t)b * SEQ + t0 + 16 * wid) * 1024 + (g * 4 + r) * 64 + 8 * lg;
        u32x4 rk[NB_ST][2], rv[NB_ST][2];
#pragma unroll
        for (int q = 0; q < NB_ST; ++q) if (q <= cur) { tile_ld(Kg + (size_t)q * 4096, 64, rk[q]); tile_ld(Vg + (size_t)q * 4096, 64, rv[q]); }
        __syncthreads();
        unsigned m16n = __builtin_amdgcn_readfirstlane((tmask[wid >> 1] >> ((wid & 1) * 16)) & 0xffffu);
        int tln = m16n ? kth_bit4(m16n, tsl) : 0;
        bf16x8 qn0 = *(const bf16x8*)(qbase + (size_t)tln * 1024), qn1 = *(const bf16x8*)(qbase + (size_t)tln * 1024 + 32);
        static_assert(NB_ST == 2, "the stage body below is written for two blocks per stage");
        for (int j0 = 0; j0 <= cur; j0 += NB_ST) {
            __syncthreads();
#pragma unroll
            for (int q = 0; q < NB_ST; ++q) if (j0 + q <= cur) { tile_st(Tl + q * NB_TILE, rk[q]); tile_st(Tl + q * NB_TILE + 64 * KS, rv[q]); }
            __syncthreads();
            const unsigned m16a = m16n; const int tla = tln; const bf16x8 qa0 = qn0, qa1 = qn1;
            unsigned m16b = 0u; int tlb = 0; bf16x8 qb0 = qn0, qb1 = qn1;
            if (j0 + 1 <= cur) {
                m16b = __builtin_amdgcn_readfirstlane((tmask[(j0 + 1) * 2 + (wid >> 1)] >> ((wid & 1) * 16)) & 0xffffu);
                tlb = m16b ? kth_bit4(m16b, tsl) : 0;
                qb0 = *(const bf16x8*)(qbase + (size_t)tlb * 1024); qb1 = *(const bf16x8*)(qbase + (size_t)tlb * 1024 + 32);
            }
            if (j0 + 2 <= cur) {
                m16n = __builtin_amdgcn_readfirstlane((tmask[(j0 + 2) * 2 + (wid >> 1)] >> ((wid & 1) * 16)) & 0xffffu);
                tln = m16n ? kth_bit4(m16n, tsl) : 0;
                qn0 = *(const bf16x8*)(qbase + (size_t)tln * 1024); qn1 = *(const bf16x8*)(qbase + (size_t)tln * 1024 + 32);
            }
#pragma unroll
            for (int q = 0; q < NB_ST; ++q) if (j0 + NB_ST + q <= cur && dry_i != 3) { tile_ld(Kg + (size_t)(j0 + NB_ST + q) * 4096, 64, rk[q]); tile_ld(Vg + (size_t)(j0 + NB_ST + q) * 4096, 64, rv[q]); }
#pragma unroll
            for (int q = 0; q < NB_ST; ++q) {
                const int j = j0 + q;
                if (j > cur) continue;
                const unsigned m16 = q ? m16b : m16a; const int tl0 = q ? tlb : tla; const bf16x8 q0 = q ? qb0 : qa0, q1 = q ? qb1 : qa1;
                if (m16 == 0u || dry_i == 2) continue;
                const int n = __popc(m16);
                const bool diag = (j == cur);
                const bf16_t* Kq = Tl + q * NB_TILE; const bf16_t* Vq = Kq + 64 * KS;
                nsa_b_cgroup(Kq, Vq, Mst, Lst, Ost, q0, q1, 16 * wid + tl0, tsl < n, diag || n < 4, diag, r, lr, lg, ones);
                unsigned mg = m16;
                for (int gi = 1; gi * 4 < n; ++gi) {
                    mg &= mg - 1u; mg &= mg - 1u; mg &= mg - 1u; mg &= mg - 1u;
                    const int tl = kth_bit4(mg, tsl);
                    const bf16x8 a0 = *(const bf16x8*)(qbase + (size_t)tl * 1024), a1 = *(const bf16x8*)(qbase + (size_t)tl * 1024 + 32);
                    nsa_b_cgroup(Kq, Vq, Mst, Lst, Ost, a0, a1, 16 * wid + tl, 4 * gi + tsl < n, diag || n - 4 * gi < 4, diag, r, lr, lg, ones);
                }
            }
        }
#pragma unroll
        for (int c = 0; c < 4; ++c) {
            const int tloc = 16 * wid + 4 * c + tsl, col = tloc * 4 + r;
            const float lt = Lst[col];
            const size_t tok = (size_t)b * SEQ + t0 + tloc;
            const float sc = (lt > 0.f) ? p.gates0[tok * 48 + 16 + g * 4 + r] / lt : 0.f;
            bf16_t* op = p.o0 + tok * 1024 + (g * 4 + r) * 64;
            bf16_t* dp = dry ? (p.xn + tok * 1024 + (g * 4 + r) * 64) : op;
#pragma unroll
            for (int db = 0; db < 4; ++db) {
                const u32x2 ov = *(const u32x2*)(Ost + col * OST + 16 * db + 4 * lg);
                const u32x2 old = *(const u32x2*)(op + 16 * db + 4 * lg);
                u32x2 w;
                w.x = pack2(bflo(old.x) + bflo(ov.x) * sc, bfhi(old.x) + bfhi(ov.x) * sc);
                w.y = pack2(bflo(old.y) + bflo(ov.y) * sc, bfhi(old.y) + bfhi(ov.y) * sc);
                *(u32x2*)(dp + 16 * db + 4 * lg) = w;
            }
        }
    }
}

DI void ins16(unsigned (&t)[16], unsigned x) {
#pragma unroll
    for (int i = 0; i < 16; ++i) { const unsigned hi = max(t[i], x); x = min(t[i], x); t[i] = hi; }
}
DI void cex(unsigned& a, unsigned& b) { const unsigned hi = max(a, b), lo = min(a, b); a = hi; b = lo; }
DI void sort16_desc(unsigned (&v)[16]) {
#pragma unroll
    for (int k = 2; k <= 16; k <<= 1)
#pragma unroll
        for (int j = k >> 1; j >= 1; j >>= 1)
#pragma unroll
            for (int i = 0; i < 16; ++i) {
                const int l = i ^ j;
                if (l > i) { if ((i & k) == 0) cex(v[i], v[l]); else cex(v[l], v[i]); }
            }
}
DI void merge16_desc(unsigned (&t)[16], const unsigned (&c)[16]) {
#pragma unroll
    for (int i = 0; i < 16; ++i) t[i] = max(t[i], c[15 - i]);
#pragma unroll
    for (int j = 8; j >= 1; j >>= 1)
#pragma unroll
        for (int i = 0; i < 16; ++i) { const int l = i ^ j; if (l > i) cex(t[i], t[l]); }
}
DI void phase_topk(const Params& p, char* smem) {
    float* svals = (float*)smem;
    int* sidx = (int*)(svals + 256 * 17);
    const int tid = threadIdx.x;
    for (int blk = blockIdx.x; blk < NTOK / 16; blk += gridDim.x) {
        const int token = blk * 16 + (tid >> 4), list = tid & 15;
        const float* sp = p.scores + (size_t)token * 2048 + list * 128;
        unsigned tk[16];
#pragma unroll
        for (int i = 0; i < 16; ++i) tk[i] = 0u;
#pragma unroll 2
        for (int c = 0; c < 128; c += 16) {
            unsigned ck[16];
#pragma unroll
            for (int q = 0; q < 4; ++q) {
                const f32x4 v = *(const f32x4*)(sp + c + 4 * q);
#pragma unroll
                for (int e = 0; e < 4; ++e) ck[4 * q + e] = (ordf(v[e]) & 0xffffff80u) | (unsigned)(127 - (c + 4 * q + e));
            }
            sort16_desc(ck);
            merge16_desc(tk, ck);
        }
#pragma unroll
        for (int i = 0; i < 16; ++i) { svals[tid * 17 + i] = unordf(tk[i] & 0xffffff80u); sidx[tid * 17 + i] = 127 - (int)(tk[i] & 127u); }
        __syncthreads();
        if ((tid & 1) == 0) {
            unsigned t2[16];
#pragma unroll
            for (int i = 0; i < 16; ++i) t2[i] = 0u;
#pragma unroll
            for (int i = 0; i < 16; ++i) {
                const float a = svals[tid * 17 + i];
#pragma unroll
                for (int j = 0; j < 16; ++j)
                    if ((i + 1) * (j + 1) <= 16) ins16(t2, (ordf(a + svals[(tid + 1) * 17 + j]) & 0xffffff00u) | (unsigned)(255 - (i * 16 + j)));
            }
            const float smax = unordf(t2[0] & 0xffffff00u);
            float e[16], se = 0.f;
#pragma unroll
            for (int k = 0; k < 16; ++k) { e[k] = __expf(unordf(t2[k] & 0xffffff00u) - smax); se += e[k]; }
            const float inv = 1.0f / se;
            const size_t ob = ((size_t)token * 8 + (list >> 1)) * 16;
#pragma unroll
            for (int k = 0; k < 16; ++k) {
                const int pos = 255 - (int)(t2[k] & 255u), i = pos >> 4, j = pos & 15;
                p.eidx[ob + k] = sidx[tid * 17 + i] * 128 + sidx[(tid + 1) * 17 + j];
                p.egate[ob + k] = e[k] * inv;
            }
        }
        __syncthreads();
    }
}

DI void unpack16_fp8(const u32x4 r, float (&o)[16]) {
#pragma unroll
    for (int q = 0; q < 4; ++q) {
        const f32x2 lo = __builtin_amdgcn_cvt_pk_f32_fp8((int)r[q], false), hi = __builtin_amdgcn_cvt_pk_f32_fp8((int)r[q], true);
        o[4 * q] = lo.x; o[4 * q + 1] = lo.y; o[4 * q + 2] = hi.x; o[4 * q + 3] = hi.y;
    }
}
DI void reduce16(const float (&d)[16], int lane, float& c0, float& c1) {
    float a[8], b[4];
#pragma unroll
    for (int j = 0; j < 8; ++j) a[j] = swap32_add(d[j], d[j + 8]);
#pragma unroll
    for (int j = 0; j < 4; ++j) b[j] = swap16_add(a[j], a[j + 4]);
    const bool hi = lane & 8;
    const float k0 = hi ? b[2] : b[0], s0 = hi ? b[0] : b[2], k1 = hi ? b[3] : b[1], s1 = hi ? b[1] : b[3];
    c0 = octet_sum(k0 + dppf<0x128>(s0)); c1 = octet_sum(k1 + dppf<0x128>(s1));
}
DI float reduce8(const float (&d)[8], int lane) {
    float a[4], b[2];
#pragma unroll
    for (int j = 0; j < 4; ++j) a[j] = swap32_add(d[j], d[j + 4]);
#pragma unroll
    for (int j = 0; j < 2; ++j) b[j] = swap16_add(a[j], a[j + 2]);
    const bool hi = lane & 8;
    return octet_sum((hi ? b[1] : b[0]) + dppf<0x128>(hi ? b[0] : b[1]));
}
DI float dot16_fp8(const u32x4 r, const u32x4 x) {
    int acc = __builtin_amdgcn_sdot4((int)r.x, (int)x.x, 0, false);
    acc = __builtin_amdgcn_sdot4((int)r.y, (int)x.y, acc, false);
    acc = __builtin_amdgcn_sdot4((int)r.z, (int)x.z, acc, false);
    acc = __builtin_amdgcn_sdot4((int)r.w, (int)x.w, acc, false);
    return (float)acc;
}
DI void phase_peer_u(const Params& p, char* smem, const int dry_i) {
    const bool dry = dry_i != 0;
    const int lane = threadIdx.x & 63, wid = threadIdx.x >> 6;
    const int part0 = blockIdx.x & 7, rank = blockIdx.x >> 3, nrank = (gridDim.x - part0 + 7) >> 3;
    const int part = (dry_i == 4) ? (int)(xb_xcc_id() & 7u) : part0;
    int* Lbase = (int*)smem + wid * 768;
    float* cdst = dry ? p.scores : p.coef;
    const int j16 = ((lane >> 5) & 1) * 8 + ((lane >> 4) & 1) * 4 + ((lane >> 3) & 1) * 2 + (lane & 1);
    const int j8 = ((lane >> 5) & 1) * 4 + ((lane >> 4) & 1) * 2 + ((lane >> 3) & 1);
    const int tstride = nrank * 4;
    int t = rank * 4 + wid;
    int ev0 = 0, ev1 = 0; float gv0 = 0.f, gv1 = 0.f; u32x4 xraw = (u32x4){0u, 0u, 0u, 0u};
#define U_LOAD_RAW(tt) do { ev0 = p.eidx[(size_t)(tt) * 128 + lane]; ev1 = p.eidx[(size_t)(tt) * 128 + 64 + lane]; gv0 = p.egate[(size_t)(tt) * 128 + lane]; gv1 = p.egate[(size_t)(tt) * 128 + 64 + lane]; \
        xraw = *(const u32x4*)(p.xq8 + (size_t)(tt) * 1024 + 16 * lane); } while (0)
#define U_BUILD_LIST(buf, nout) do { int* L_idx_ = Lbase + (buf) * 384; float* L_gate_ = (float*)(L_idx_ + 128); int* L_pos_ = L_idx_ + 256; \
        const bool in0 = (ev0 >> 11) == part, in1 = (ev1 >> 11) == part; \
        const unsigned long long mk0 = __ballot(in0), mk1 = __ballot(in1); \
        const int n0_ = __popcll(mk0); nout = n0_ + __popcll(mk1); \
        asm volatile("" ::: "memory"); \
        if (in0) { const int r0 = __builtin_amdgcn_mbcnt_hi((unsigned)(mk0 >> 32), __builtin_amdgcn_mbcnt_lo((unsigned)mk0, 0u)); L_idx_[r0] = ev0; L_gate_[r0] = gv0; L_pos_[r0] = lane; } \
        if (in1) { const int r1 = n0_ + __builtin_amdgcn_mbcnt_hi((unsigned)(mk1 >> 32), __builtin_amdgcn_mbcnt_lo((unsigned)mk1, 0u)); L_idx_[r1] = ev1; L_gate_[r1] = gv1; L_pos_[r1] = 64 + lane; } \
        asm volatile("s_waitcnt lgkmcnt(0)" ::: "memory"); } while (0)
    int nC = 0, cb = 0; u32x4 xC = xraw; u32x4 rrC[16];
#pragma unroll
    for (int j = 0; j < 16; ++j) rrC[j] = (u32x4){0u, 0u, 0u, 0u};
    if (t < NTOK) {
        U_LOAD_RAW(t);
        U_BUILD_LIST(0, nC); xC = xraw;
        const int* L_idx = Lbase;
#pragma unroll
        for (int j = 0; j < 16; ++j) rrC[j] = *(const u32x4*)(p.u8 + (size_t)(L_idx[j < nC ? j : 0] & 16383) * 1024 + 16 * lane);
        if (t + tstride < NTOK) U_LOAD_RAW(t + tstride);
    }
    for (; t < NTOK; t += tstride) {
        const int tn = t + tstride;
        int nN = 0; u32x4 xN = xraw; u32x4 rrN[16];
        if (tn < NTOK) {
            U_BUILD_LIST(cb ^ 1, nN); xN = xraw;
            const int* Ln = Lbase + (cb ^ 1) * 384;
#pragma unroll
            for (int j = 0; j < 16; ++j) rrN[j] = *(const u32x4*)(p.u8 + (size_t)(Ln[j < nN ? j : 0] & 16383) * 1024 + 16 * lane);
            if (tn + tstride < NTOK) U_LOAD_RAW(tn + tstride);
        } else {
#pragma unroll
            for (int j = 0; j < 16; ++j) rrN[j] = (u32x4){0u, 0u, 0u, 0u};
        }
        const int* L_idx = Lbase + cb * 384; const float* L_gate = (const float*)(L_idx + 128); const int* L_pos = L_idx + 256;
        const int n = nC;
        u32x4 r2[8];
        const bool more = n > 16;
        if (more) {
#pragma unroll
            for (int j = 0; j < 8; ++j) { const int sl = 16 + j; r2[j] = *(const u32x4*)(p.u8 + (size_t)(L_idx[sl < n ? sl : 0] & 16383) * 1024 + 16 * lane); }
        }
        if (n > 0) {
            float d[16];
#pragma unroll
            for (int j = 0; j < 16; ++j) d[j] = dot16_fp8(rrC[j], xC);
            float c0, c1; reduce16(d, lane, c0, c1);
            { const int sl = j16; if ((lane & 7) < 2 && sl < n) cdst[(size_t)t * 128 + L_pos[sl]] = gelu_tanh(((lane & 1) ? c1 : c0) * (1.0f / (U8_SCALE * X8_SCALE))) * L_gate[sl] * FP8_INV; }
        }
        if (more) {
            float d2[8];
#pragma unroll
            for (int j = 0; j < 8; ++j) d2[j] = dot16_fp8(r2[j], xC);
            const float tot2 = reduce8(d2, lane);
            const int sl = 16 + j8; if ((lane & 7) == 0 && sl < n) cdst[(size_t)t * 128 + L_pos[sl]] = gelu_tanh(tot2 * (1.0f / (U8_SCALE * X8_SCALE))) * L_gate[sl] * FP8_INV;
        }
        for (int base = 24; base < n; base += 8) {
            float d2[8];
#pragma unroll
            for (int j = 0; j < 8; ++j) { const int sl = base + j; d2[j] = dot16_fp8(*(const u32x4*)(p.u8 + (size_t)L_idx[sl < n ? sl : 0] * 1024 + 16 * lane), xC); }
            const float tot2 = reduce8(d2, lane);
            const int sl = base + j8; if ((lane & 7) == 0 && sl < n) cdst[(size_t)t * 128 + L_pos[sl]] = gelu_tanh(tot2 * (1.0f / (U8_SCALE * X8_SCALE))) * L_gate[sl] * FP8_INV;
        }
        asm volatile("" ::: "memory");
        nC = nN; xC = xN; cb ^= 1;
#pragma unroll
        for (int j = 0; j < 16; ++j) rrC[j] = rrN[j];
    }
}
DI void phase_peer_v(const Params& p, const bool dry) {
    const int lane = threadIdx.x & 63, wid = threadIdx.x >> 6, pg = lane >> 3, li = lane & 7;
    const int sl = blockIdx.x & 7, rank = blockIdx.x >> 3, nrank = (gridDim.x - sl + 7) >> 3;
    const unsigned char* vt = p.v8s + (size_t)sl * 16384 * 128 + 16 * li;
    int t = rank * 4 + wid;
    int e0 = 0, e1 = 0; float c0 = 0.f, c1 = 0.f;
    if (t < NTOK) { e0 = p.eidx[(size_t)t * 128 + lane]; e1 = p.eidx[(size_t)t * 128 + 64 + lane]; c0 = p.coef[(size_t)t * 128 + lane]; c1 = p.coef[(size_t)t * 128 + 64 + lane]; }
    for (; t < NTOK; t += nrank * 4) {
        const int tn = t + nrank * 4;
        const size_t o = (size_t)t * 1024 + 128 * sl + 16 * li + 2 * pg;
        f32x2 acc[8];
#pragma unroll
        for (int j = 0; j < 8; ++j) acc[j] = (f32x2){0.f, 0.f};
        u32x4 r[16]; float c[16];
#pragma unroll
        for (int k = 0; k < 16; ++k) {
            const int src = (8 * k + pg) & 63;
            const int e = __shfl(k < 8 ? e0 : e1, src);
            c[k] = __shfl(k < 8 ? c0 : c1, src);
            r[k] = *(const u32x4*)(vt + (size_t)e * 128);
        }
        __builtin_amdgcn_sched_barrier(0);
        f32x2 cur = *(const f32x2*)(p.out + o);
        int ne0 = 0, ne1 = 0; float nc0 = 0.f, nc1 = 0.f;
        if (tn < NTOK) { ne0 = p.eidx[(size_t)tn * 128 + lane]; ne1 = p.eidx[(size_t)tn * 128 + 64 + lane]; nc0 = p.coef[(size_t)tn * 128 + lane]; nc1 = p.coef[(size_t)tn * 128 + 64 + lane]; }
        __builtin_amdgcn_sched_barrier(0);
#pragma unroll
        for (int k = 0; k < 16; ++k) {
            const f32x2 ck = {c[k], c[k]};
#pragma unroll
            for (int q = 0; q < 4; ++q) {
                acc[2 * q] += ck * __builtin_amdgcn_cvt_pk_f32_fp8((int)r[k][q], false);
                acc[2 * q + 1] += ck * __builtin_amdgcn_cvt_pk_f32_fp8((int)r[k][q], true);
            }
        }
        float a8[8], a4[4], a2[2];
#pragma unroll
        for (int j = 0; j < 4; ++j) { a8[2 * j] = swap32_add(acc[j].x, acc[j + 4].x); a8[2 * j + 1] = swap32_add(acc[j].y, acc[j + 4].y); }
#pragma unroll
        for (int j = 0; j < 4; ++j) a4[j] = swap16_add(a8[j], a8[j + 4]);
        {
            const bool hi = pg & 1;
            a2[0] = (hi ? a4[2] : a4[0]) + dppf<0x128>(hi ? a4[0] : a4[2]);
            a2[1] = (hi ? a4[3] : a4[1]) + dppf<0x128>(hi ? a4[1] : a4[3]);
        }
        cur.x += a2[0]; cur.y += a2[1];
        *(f32x2*)((dry ? p.scores : p.out) + o) = cur;
        e0 = ne0; e1 = ne1; c0 = nc0; c1 = nc1;
    }
}

DI void phase_cumsum(const Params& p, char* smem) {
    float* part = (float*)smem;
    const int tid = threadIdx.x;
    for (int u = blockIdx.x; u < 512; u += gridDim.x) {
        const int bh = u >> 4, ch = u & 15, b = bh >> 4, h = bh & 15, sub = tid & 7;
        float kmax = 0.f, qmax = 0.f;
        for (int it = 0; it < 32; ++it) {
            const int s = ch * 1024 + it * 32 + (tid >> 3);
            const u32x4 kv = *(const u32x4*)(p.k1 + ((size_t)bh * SEQ + s) * 64 + sub * 8);
            const u32x4 qv = *(const u32x4*)(p.q1 + ((size_t)b * SEQ + s) * 1024 + h * 64 + sub * 8);
            float ks = 0.f, qs = 0.f;
#pragma unroll
            for (int i = 0; i < 4; ++i) { ks += bflo(kv[i]) * bflo(kv[i]) + bfhi(kv[i]) * bfhi(kv[i]); qs += bflo(qv[i]) * bflo(qv[i]) + bfhi(qv[i]) * bfhi(qv[i]); }
            ks += __shfl_xor(ks, 1); ks += __shfl_xor(ks, 2); ks += __shfl_xor(ks, 4);
            qs += __shfl_xor(qs, 1); qs += __shfl_xor(qs, 2); qs += __shfl_xor(qs, 4);
            kmax = fmaxf(kmax, ks); qmax = fmaxf(qmax, qs);
        }
#pragma unroll
        for (int off = 8; off <= 32; off <<= 1) { kmax = fmaxf(kmax, __shfl_xor(kmax, off)); qmax = fmaxf(qmax, __shfl_xor(qmax, off)); }
        if ((tid & 63) == 0) { atomicMax(&p.nrm[bh * 2], __float_as_uint(kmax * 1.02f)); atomicMax(&p.nrm[bh * 2 + 1], __float_as_uint(qmax * 1.02f)); }
    }
    for (int seq = blockIdx.x; seq < 32; seq += gridDim.x) {
        float* c = p.cfox + (size_t)seq * SEQ + tid * 64;
        float s = 0.f;
        for (int i = 0; i < 64; i += 4) { const f32x4 v = *(const f32x4*)(c + i); s += (v[0] + v[1]) + (v[2] + v[3]); }
        __syncthreads();
        part[tid] = s;
        __syncthreads();
        float run = 0.f;
        for (int i = 0; i < tid; ++i) run += part[i];
        for (int i = 0; i < 64; i += 4) {
            f32x4 v = *(const f32x4*)(c + i);
            v[0] += run; v[1] += v[0]; v[2] += v[1]; v[3] += v[2]; run = v[3];
            *(f32x4*)(c + i) = v;
        }
    }
}

constexpr int N_PHASES = 23;
#ifndef PROBE_PHASE
#define PROBE_PHASE -1
#endif
#ifndef PROBE_DRY
#define PROBE_DRY 1
#endif
constexpr int cmax(int a, int b) { return a > b ? a : b; }
constexpr int LDS_BYTES = 16 + 64 + cmax(cmax(NSB_LDS, 384 * GS * 2), 2 * 64 * KS * 2 + 32 * IST * 4);
static_assert(LDS_BYTES >= 16 + 256 * 17 * 8, "topk tables must fit");

__global__ void __launch_bounds__(256, 2) mega(Params p, int ph_lo, int ph_hi, int dry_i) {
    const bool dry = dry_i != 0;
    extern __shared__ __attribute__((aligned(16))) char smem_all[];
    char* smem = smem_all + 16;
    const bool multi = (ph_hi - ph_lo) > 1;
    XcdBarrier bar;
    if (multi) {
        if (threadIdx.x == 0) *(uint4*)smem_all = make_uint4(0u, 0u, 0u, 0u);
        __syncthreads();
        bar = xcd_barrier_post(p.bar, (volatile LAS unsigned*)smem_all);
    }
#define PHASE(i, ...) if (ph_lo <= (i) && (i) < ph_hi) { __VA_ARGS__; if ((i) + 1 < ph_hi) xcd_barrier(bar); }
    PHASE(0, phase_prologue(p))
    PHASE(1, phase_gemm_in0(p, smem))
    PHASE(2, phase_cmp1(p, smem))
    PHASE(3, phase_cmp2(p, smem))
    PHASE(4, phase_nsa_a(p, smem))
    PHASE(5, phase_nsa_b(p, smem, dry_i))
    PHASE(6, phase_gemm_out(p.o0, p.wt_out0, p.x, p.out, smem))
    PHASE(7, rmsnorm_pipe<1>(p.out, p.l0_ffn_norm, p.xn, nullptr, p.xq8))
    PHASE(8, phase_gemm_scores(p, p.weff0, smem))
    PHASE(9, phase_topk(p, smem))
    PHASE(10, phase_peer_u(p, smem, dry_i))
    PHASE(11, phase_peer_v(p, dry))
    PHASE(12, { rmsnorm_pipe<0>(p.out, p.l1_attn_norm, p.xn, nullptr, nullptr);
                const int gtid = blockIdx.x * blockDim.x + threadIdx.x, gsz = gridDim.x * blockDim.x;
                convert_tables_fp8(p.l1_u, p.l1_v, p.u8, p.v8s, gtid, gsz); if (gtid < 64) p.nrm[gtid] = 0u; })
    PHASE(13, phase_gemm_in1(p, smem))
    PHASE(14, phase_cumsum(p, smem))
    PHASE(15, phase_fox(p, smem))
    PHASE(16, phase_gemm_out(p.o1, p.wt_out1, p.out, p.out, smem))
    PHASE(17, rmsnorm_pipe<1>(p.out, p.l1_ffn_norm, p.xn, nullptr, p.xq8))
    PHASE(18, phase_gemm_scores(p, p.weff1, smem))
    PHASE(19, phase_topk(p, smem))
    PHASE(20, phase_peer_u(p, smem, dry_i))
    PHASE(21, phase_peer_v(p, dry))
    PHASE(22, rmsnorm_pipe<2>(p.out, p.final_norm, nullptr, p.out, nullptr))
#undef PHASE
}

#ifndef MK_ONE_LAUNCH
#define MK_ONE_LAUNCH 1
#endif
extern "C" void kernel_launch(void* const* d_in, const int* in_sizes, int n_in, void* d_out, int out_size, void* d_ws, size_t ws_size, hipStream_t stream) {
    (void)in_sizes; (void)n_in; (void)out_size;
    Params p{};
    const float* const* in = (const float* const*)d_in;
    p.x = in[0]; p.l0_attn_norm = in[1]; p.l0_w_in = in[2]; p.l0_pe_k = in[3]; p.l0_w1_k = in[4]; p.l0_w2_k = in[5]; p.l0_pe_v = in[6]; p.l0_w1_v = in[7]; p.l0_w2_v = in[8];
    p.l0_w_out = in[9]; p.l0_ffn_norm = in[10]; p.l0_wq = in[11]; p.l0_keys = in[12]; p.l0_u = in[13]; p.l0_v = in[14];
    p.l1_attn_norm = in[15]; p.l1_w_in = in[16]; p.l1_f_bias = in[17]; p.l1_w_out = in[18]; p.l1_ffn_norm = in[19]; p.l1_wq = in[20]; p.l1_keys = in[21]; p.l1_u = in[22]; p.l1_v = in[23];
    p.final_norm = in[24];
    p.out = (float*)d_out;
    char* w = (char*)d_ws; size_t off = 0;
    auto take = [&](size_t bytes) { char* r = w + off; off += (bytes + 255) & ~(size_t)255; return r; };
    p.bar = (unsigned*)take(XCD_BAR_WORDS * 4);
    p.rope = (float2*)take((size_t)SEQ * 32 * 8);
    p.wt_in0 = (bf16_t*)take((size_t)NSA_NP * 1024 * 2); p.wt_out0 = (bf16_t*)take((size_t)1024 * 1024 * 2);
    p.wq0b = (bf16_t*)take((size_t)1024 * 2048 * 2); p.keys0b = (bf16_t*)take((size_t)16 * 128 * 128 * 2); p.weff0 = (bf16_t*)take((size_t)2048 * 1024 * 2);
    p.wt_in1 = (bf16_t*)take((size_t)FOX_NP * 1024 * 2); p.wt_out1 = (bf16_t*)take((size_t)1024 * 1024 * 2);
    p.wq1b = (bf16_t*)take((size_t)1024 * 2048 * 2); p.keys1b = (bf16_t*)take((size_t)16 * 128 * 128 * 2); p.weff1 = (bf16_t*)take((size_t)2048 * 1024 * 2);
    p.w1t = (bf16_t*)take((size_t)8 * 128 * 2048 * 2); p.w2t = (bf16_t*)take((size_t)8 * 128 * 128 * 2); p.b1 = (float*)take(16 * 1024 * 4);
    p.u8 = (unsigned char*)take((size_t)16384 * 1024); p.v8s = (unsigned char*)take((size_t)16384 * 1024); p.coef = (float*)take((size_t)NTOK * 128 * 4);
    p.xn = (bf16_t*)take((size_t)NTOK * 1024 * 2); p.xq8 = (unsigned char*)take((size_t)NTOK * 1024);
    p.eidx = (int*)take((size_t)NTOK * 128 * 4); p.egate = (float*)take((size_t)NTOK * 128 * 4);
    p.cfox = (float*)take((size_t)32 * SEQ * 4); p.nrm = (unsigned*)take(256);
    char* act = take((size_t)256 << 20);
    {
        size_t a = 0; auto tk = [&](size_t bytes) { char* r = act + a; a += (bytes + 255) & ~(size_t)255; return r; };
        p.q0 = (bf16_t*)tk((size_t)NTOK * 1024 * 2);
        p.kcin = (bf16_t*)tk((size_t)8 * SEQ * 64 * 2); p.vcin = (bf16_t*)tk((size_t)8 * SEQ * 64 * 2); p.kslc = (bf16_t*)tk((size_t)8 * SEQ * 64 * 2);
        p.vslcT = (bf16_t*)tk((size_t)8 * SEQ * 64 * 2); p.kwin = (bf16_t*)tk((size_t)8 * SEQ * 64 * 2); p.vwinT = (bf16_t*)tk((size_t)8 * SEQ * 64 * 2);
        p.o0 = (bf16_t*)tk((size_t)NTOK * 1024 * 2);
        p.gates0 = (float*)tk((size_t)NTOK * 48 * 4); p.sel = (int*)tk((size_t)NTOK * 64 * 4);
        p.kcmp = (bf16_t*)tk((size_t)8 * 1024 * 64 * 2); p.vcmpT = (bf16_t*)tk((size_t)8 * 1024 * 64 * 2); p.hid = (bf16_t*)tk((size_t)16 * 1024 * 128 * 2);
        if (a > ((size_t)256 << 20)) { fprintf(stderr, "activation overlay too large\n"); return; }
        p.scores = (float*)act;
        p.q1 = (bf16_t*)act; p.k1 = p.q1 + (size_t)NTOK * 1024; p.v1T = p.k1 + (size_t)NTOK * 1024; p.o1 = p.v1T + (size_t)NTOK * 1024;
    }
    if (off > ws_size) { fprintf(stderr, "workspace too small: need %zu have %zu\n", off, ws_size); return; }

    static int grid = 0;
    if (!grid) {
        int dev = 0, cus = 0, per_cu = 0;
        hipGetDevice(&dev);
        hipDeviceGetAttribute(&cus, hipDeviceAttributeMultiprocessorCount, dev);
        if (hipFuncSetAttribute((const void*)mega, hipFuncAttributeMaxDynamicSharedMemorySize, LDS_BYTES) != hipSuccess) fprintf(stderr, "kernel_launch: hipFuncSetAttribute(%d B LDS) failed\n", LDS_BYTES);
        hipOccupancyMaxActiveBlocksPerMultiprocessor(&per_cu, mega, 256, LDS_BYTES);
        if (per_cu > 2) per_cu = 2;
        if (per_cu < 1) per_cu = 1;
        grid = cus * per_cu;
    }
#if PROBE_PHASE >= 0
    for (int i = 0; i < N_PHASES; ++i) {
        if (i == PROBE_PHASE) hipLaunchKernelGGL(mega, dim3(grid), dim3(256), LDS_BYTES, stream, p, i, i + 1, PROBE_DRY);
        hipLaunchKernelGGL(mega, dim3(grid), dim3(256), LDS_BYTES, stream, p, i, i + 1, 0);
    }
#elif MK_ONE_LAUNCH
    hipMemsetAsync(p.bar, 0, XCD_BAR_WORDS * 4, stream);
    hipLaunchKernelGGL(mega, dim3(grid), dim3(256), LDS_BYTES, stream, p, 0, N_PHASES, 0);
#else
    for (int i = 0; i < N_PHASES; ++i) hipLaunchKernelGGL(mega, dim3(grid), dim3(256), LDS_BYTES, stream, p, i, i + 1, 0);
#endif
}
```

```cpp
#include <hip/hip_runtime.h>
#include <stdint.h>
#include <stdio.h>

#define DI __device__ __forceinline__
typedef unsigned short bf16_t;
typedef short bf16x8 __attribute__((ext_vector_type(8)));
typedef short s16x4 __attribute__((ext_vector_type(4)));
typedef float f32x4 __attribute__((ext_vector_type(4)));
typedef float f32x16 __attribute__((ext_vector_type(16)));
typedef unsigned u32x4 __attribute__((ext_vector_type(4)));
typedef unsigned u32x2 __attribute__((ext_vector_type(2)));

constexpr int DM = 1024, BATCH = 2, SEQ = 16384, NTOK = BATCH * SEQ;
constexpr int NSA_N = 2608, NSA_NP = 2816, FOX_N = 3088, FOX_NP = 3328;
constexpr float LOG2E = 1.4426950408889634f;
#define NEGINF (-__builtin_inff())

#define XB_TMO      128
#define XB_XCNT(j)  (256  + 64 * (j))
#define XB_XSUB(j)  (1280 + 64 * (j))
#define XB_XGEN(j)  (2304 + 64 * (j))
#define XB_TOP      3328
#define XB_TOPGEN   3392
#define XCD_BAR_WORDS 3456
#define XB_SPIN_CAP (1u << 18)
#define LAS __attribute__((address_space(3)))

__device__ __forceinline__ unsigned xb_ld(unsigned* p)              { return __hip_atomic_load(p, __ATOMIC_RELAXED, __HIP_MEMORY_SCOPE_AGENT); }
__device__ __forceinline__ unsigned xb_add(unsigned* p, unsigned v) { return __hip_atomic_fetch_add(p, v, __ATOMIC_RELAXED, __HIP_MEMORY_SCOPE_AGENT); }
__device__ __forceinline__ unsigned xb_xcc_id() { return (unsigned)__builtin_amdgcn_s_getreg((3 << 11) | 20) & 0xFu; }
#define XB_SPIN(cond, bar) do { unsigned _sp = 0; while (cond) { __builtin_amdgcn_s_sleep(1); \
    if ((++_sp & 255u) == 0u) { if (xb_ld(&(bar)[XB_TMO])) break; if (_sp > XB_SPIN_CAP) { atomicAdd(&(bar)[XB_TMO], 1u); break; } } } } while (0)

struct XcdBarrier { unsigned* bar; unsigned x; volatile LAS unsigned* st; };

__device__ __forceinline__ XcdBarrier xcd_barrier_post(unsigned* bar, volatile LAS unsigned* st) {
    XcdBarrier b; b.bar = bar; b.x = xb_xcc_id(); b.st = st;
    if (threadIdx.x == 0) (void)xb_add(&bar[XB_XCNT(b.x)], 1u);
    return b;
}
__device__ __forceinline__ void xcd_barrier_complete(unsigned* bar, unsigned x, unsigned& nloc, unsigned& nx) {
    const unsigned G = gridDim.x * gridDim.y * gridDim.z;
    unsigned sum, cnt, mine, sp = 0u;
    for (;;) {
        sum = 0u; cnt = 0u; mine = 0u;
#pragma unroll
        for (unsigned j = 0; j < 16; ++j) { const unsigned c = xb_ld(&bar[XB_XCNT(j)]); sum += c; cnt += (c > 0u) ? 1u : 0u; mine = (j == x) ? c : mine; }
        if (sum == G) break;
        __builtin_amdgcn_s_sleep(1);
        if ((++sp & 255u) == 0u) { if (xb_ld(&bar[XB_TMO])) break; if (sp > XB_SPIN_CAP) { atomicAdd(&bar[XB_TMO], 1u); break; } }
    }
    nloc = mine > 0u ? mine : 1u; nx = cnt > 0u ? cnt : 1u;
}
__device__ __forceinline__ void xcd_barrier(const XcdBarrier& b) {
    asm volatile("s_waitcnt vmcnt(0)" ::: "memory");
    __syncthreads();
    if (threadIdx.x == 0) {
        unsigned* bar = b.bar;
        __builtin_amdgcn_s_waitcnt(0);
        unsigned nloc = b.st[0], nx = b.st[1];
        if (nloc == 0u) { xcd_barrier_complete(bar, b.x, nloc, nx); b.st[0] = nloc; b.st[1] = nx; }
        const unsigned old = xb_add(&bar[XB_XSUB(b.x)], 1u);
        const unsigned gen = old / nloc;
        if (old + 1u == (gen + 1u) * nloc) {
            __builtin_amdgcn_fence(__ATOMIC_RELEASE, "agent");
            asm volatile("s_waitcnt vmcnt(0)" ::: "memory");
            const unsigned og = xb_add(&bar[XB_TOP], 1u);
            const unsigned tg = og / nx;
            if (og + 1u == (tg + 1u) * nx) xb_add(&bar[XB_TOPGEN], 1u);
            else XB_SPIN(xb_ld(&bar[XB_TOPGEN]) == tg, bar);
            __builtin_amdgcn_fence(__ATOMIC_ACQUIRE, "agent");
            xb_add(&bar[XB_XGEN(b.x)], 1u);
            asm volatile("s_waitcnt vmcnt(0)" ::: "memory");
        } else {
            XB_SPIN(xb_ld(&bar[XB_XGEN(b.x)]) == gen, bar);
            __builtin_amdgcn_fence(__ATOMIC_ACQUIRE, "agent");
            asm volatile("s_waitcnt vmcnt(0)" ::: "memory");
        }
    }
    __syncthreads();
}

struct Params {
    const float *x, *l0_attn_norm, *l0_w_in, *l0_pe_k, *l0_w1_k, *l0_w2_k, *l0_pe_v, *l0_w1_v, *l0_w2_v, *l0_w_out, *l0_ffn_norm, *l0_wq, *l0_keys, *l0_u, *l0_v;
    const float *l1_attn_norm, *l1_w_in, *l1_f_bias, *l1_w_out, *l1_ffn_norm, *l1_wq, *l1_keys, *l1_u, *l1_v, *final_norm;
    float* out;
    unsigned* bar; float2* rope;
    bf16_t *wt_in0, *wt_out0, *wq0b, *keys0b, *weff0, *wt_in1, *wt_out1, *wq1b, *keys1b, *weff1, *w1t, *w2t;
    float* b1;
    unsigned char *u8, *v8s; float* coef;
    bf16_t* xn; unsigned char* xq8;
    bf16_t *q0, *kcin, *vcin, *kslc, *vslcT, *kwin, *vwinT, *o0, *kcmp, *vcmpT, *hid;
    float* gates0; int* sel;
    float* scores; int* eidx; float* egate;
    bf16_t *q1, *k1, *v1T, *o1;
    float* cfox; unsigned* nrm;
};

DI float bf2f(bf16_t v) { return __uint_as_float((unsigned)v << 16); }
DI bf16_t f2bf(float f) { __bf16 b = (__bf16)f; return __builtin_bit_cast(bf16_t, b); }
typedef __bf16 bf16x2_t __attribute__((ext_vector_type(2)));
typedef float f32x2 __attribute__((ext_vector_type(2)));
DI unsigned pack2(float lo, float hi) { const f32x2 v = {lo, hi}; return __builtin_bit_cast(unsigned, __builtin_convertvector(v, bf16x2_t)); }
DI float bflo(unsigned w) { return __uint_as_float(w << 16); }
DI float bfhi(unsigned w) { return __uint_as_float(w & 0xffff0000u); }
DI float gelu_tanh(float x) {
    const float y = 0.7978845608028654f * (x + 0.044715f * x * x * x);
    const float e = __expf(2.0f * y);
    const float t = 1.0f - 2.0f / (e + 1.0f);
    return 0.5f * x * (1.0f + t);
}
DI unsigned ordf(float f) { const unsigned u = __float_as_uint(f); return u ^ ((u & 0x80000000u) ? 0xffffffffu : 0x80000000u); }
DI float unordf(unsigned o) { const unsigned u = o ^ ((o & 0x80000000u) ? 0x80000000u : 0xffffffffu); return __uint_as_float(u); }
#define MFMA16(a, b, c) __builtin_amdgcn_mfma_f32_16x16x32_bf16((a), (b), (c), 0, 0, 0)
#define MFMA32(a, b, c) __builtin_amdgcn_mfma_f32_32x32x16_bf16((a), (b), (c), 0, 0, 0)

DI float xhalf_max(float x) { const auto t = __builtin_amdgcn_permlane32_swap(__float_as_uint(x), __float_as_uint(x), false, false); return fmaxf(__uint_as_float(t[0]), __uint_as_float(t[1])); }
DI float xhalf_sum(float x) { const auto t = __builtin_amdgcn_permlane32_swap(__float_as_uint(x), __float_as_uint(x), false, false); return __uint_as_float(t[0]) + __uint_as_float(t[1]); }
DI float swap32_add(float x, float y) { const auto t = __builtin_amdgcn_permlane32_swap(__float_as_uint(x), __float_as_uint(y), false, false); return __uint_as_float(t[0]) + __uint_as_float(t[1]); }
DI float swap16_add(float x, float y) { const auto t = __builtin_amdgcn_permlane16_swap(__float_as_uint(x), __float_as_uint(y), false, false); return __uint_as_float(t[0]) + __uint_as_float(t[1]); }
DI float dpp_f(float x, int ctrl_unused) { return x; }
template <int CTRL> DI float dppf(float x) { return __builtin_bit_cast(float, __builtin_amdgcn_update_dpp(0, __builtin_bit_cast(int, x), CTRL, 0xF, 0xF, true)); }
DI float octet_sum(float x) { x += dppf<0xB1>(x); x += dppf<0x4E>(x); x += dppf<0x141>(x); return x; }
DI float xrow16_sum(float x) { const auto s_ = __builtin_amdgcn_permlane16_swap(__float_as_uint(x), __float_as_uint(x), false, false); return xhalf_sum(__uint_as_float(s_[0]) + __uint_as_float(s_[1])); }
DI float xrow16_max(float x) { const auto s = __builtin_amdgcn_permlane16_swap(__float_as_uint(x), __float_as_uint(x), false, false); return xhalf_max(fmaxf(__uint_as_float(s[0]), __uint_as_float(s[1]))); }
constexpr float FP8_SCALE = 256.0f, FP8_INV = 1.0f / 256.0f;
DI unsigned pack4_fp8(float a, float b, float c, float d) {
    int w = 0;
    w = __builtin_amdgcn_cvt_pk_fp8_f32(a, b, w, false);
    w = __builtin_amdgcn_cvt_pk_fp8_f32(c, d, w, true);
    return (unsigned)w;
}
constexpr int GS = 72;
template <class Epi>
DI void gemm_tile(const bf16_t* __restrict__ A, int lda, const bf16_t* __restrict__ B, int ldb, int K, int m0, int n0, const Epi& epi, bf16_t* As, bf16_t* Bs) {
    const int tid = threadIdx.x, lane = tid & 63, wid = tid >> 6, wm = wid >> 1, wn = wid & 1, lr = lane & 15, lg = lane >> 4;
    f32x4 acc[4][4];
#pragma unroll
    for (int i = 0; i < 4; ++i)
#pragma unroll
        for (int j = 0; j < 4; ++j) acc[i][j] = (f32x4){0.f, 0.f, 0.f, 0.f};
    const int crow = tid >> 3, ckc = tid & 7;
    const bf16_t* ap = A + (size_t)(m0 + crow) * lda + ckc * 8;
    const bf16_t* bp = B + (size_t)(n0 + crow) * ldb + ckc * 8;
    u32x4 ra[4], rb[4];
#pragma unroll
    for (int i = 0; i < 4; ++i) { ra[i] = *(const u32x4*)(ap + (size_t)(32 * i) * lda); rb[i] = *(const u32x4*)(bp + (size_t)(32 * i) * ldb); }
    const int nk = K >> 6;
    for (int kt = 0; kt < nk; ++kt) {
        __syncthreads();
#pragma unroll
        for (int i = 0; i < 4; ++i) { *(u32x4*)(As + (crow + 32 * i) * GS + ckc * 8) = ra[i]; *(u32x4*)(Bs + (crow + 32 * i) * GS + ckc * 8) = rb[i]; }
        __syncthreads();
        if (kt + 1 < nk) {
            ap += 64; bp += 64;
#pragma unroll
            for (int i = 0; i < 4; ++i) { ra[i] = *(const u32x4*)(ap + (size_t)(32 * i) * lda); rb[i] = *(const u32x4*)(bp + (size_t)(32 * i) * ldb); }
        }
#pragma unroll
        for (int ks = 0; ks < 2; ++ks) {
            bf16x8 a[4], b[4];
#pragma unroll
            for (int i = 0; i < 4; ++i) {
                a[i] = *(const bf16x8*)(As + (wm * 64 + i * 16 + lr) * GS + ks * 32 + lg * 8);
                b[i] = *(const bf16x8*)(Bs + (wn * 64 + i * 16 + lr) * GS + ks * 32 + lg * 8);
            }
#pragma unroll
            for (int i = 0; i < 4; ++i)
#pragma unroll
                for (int j = 0; j < 4; ++j) acc[i][j] = MFMA16(a[i], b[j], acc[i][j]);
        }
    }
    epi(acc, m0 + wm * 64, n0 + wn * 64, lr, lg);
}

template <class Epi>
DI void gemm_tile_w(const bf16_t* __restrict__ A, int lda, const bf16_t* __restrict__ B, int ldb, int K, int m0, int n0, const Epi& epi, bf16_t* As, bf16_t* Bs) {
    const int tid = threadIdx.x, lane = tid & 63, wid = tid >> 6, wm = wid >> 1, wn = wid & 1, lr = lane & 15, lg = lane >> 4;
    f32x4 acc[2][4][4];
#pragma unroll
    for (int h = 0; h < 2; ++h)
#pragma unroll
        for (int i = 0; i < 4; ++i)
#pragma unroll
            for (int j = 0; j < 4; ++j) acc[h][i][j] = (f32x4){0.f, 0.f, 0.f, 0.f};
    const int crow = tid >> 3, ckc = tid & 7;
    const bf16_t* ap = A + (size_t)(m0 + crow) * lda + ckc * 8;
    const bf16_t* bp = B + (size_t)(n0 + crow) * ldb + ckc * 8;
    u32x4 ra[4], rb[8];
#pragma unroll
    for (int i = 0; i < 4; ++i) ra[i] = *(const u32x4*)(ap + (size_t)(32 * i) * lda);
#pragma unroll
    for (int i = 0; i < 8; ++i) rb[i] = *(const u32x4*)(bp + (size_t)(32 * i) * ldb);
    const int nk = K >> 6;
    for (int kt = 0; kt < nk; ++kt) {
        __syncthreads();
#pragma unroll
        for (int i = 0; i < 4; ++i) *(u32x4*)(As + (crow + 32 * i) * GS + ckc * 8) = ra[i];
#pragma unroll
        for (int i = 0; i < 8; ++i) *(u32x4*)(Bs + (crow + 32 * i) * GS + ckc * 8) = rb[i];
        __syncthreads();
        if (kt + 1 < nk) {
            ap += 64; bp += 64;
#pragma unroll
            for (int i = 0; i < 4; ++i) ra[i] = *(const u32x4*)(ap + (size_t)(32 * i) * lda);
#pragma unroll
            for (int i = 0; i < 8; ++i) rb[i] = *(const u32x4*)(bp + (size_t)(32 * i) * ldb);
        }
#pragma unroll
        for (int ks = 0; ks < 2; ++ks) {
            bf16x8 a[4];
#pragma unroll
            for (int i = 0; i < 4; ++i) a[i] = *(const bf16x8*)(As + (wm * 64 + i * 16 + lr) * GS + ks * 32 + lg * 8);
#pragma unroll
            for (int h = 0; h < 2; ++h) {
                bf16x8 b[4];
#pragma unroll
                for (int i = 0; i < 4; ++i) b[i] = *(const bf16x8*)(Bs + (wn * 128 + h * 64 + i * 16 + lr) * GS + ks * 32 + lg * 8);
#pragma unroll
                for (int i = 0; i < 4; ++i)
#pragma unroll
                    for (int j = 0; j < 4; ++j) acc[h][i][j] = MFMA16(a[i], b[j], acc[h][i][j]);
            }
        }
    }
    epi(acc[0], m0 + wm * 64, n0 + wn * 128, lr, lg);
    epi(acc[1], m0 + wm * 64, n0 + wn * 128 + 64, lr, lg);
}
DI bool gemm_order(int it, int ntn, int& tm, int& tn) {
    const int x = blockIdx.x & 7, rank = blockIdx.x >> 3, nrank = (gridDim.x - x + 7) >> 3;
    const int li = rank + it * nrank;
    if (li >= 32 * ntn) return false;
    const int mg = li / (ntn * 8), rem = li - mg * ntn * 8;
    tn = rem >> 3; tm = x * 32 + mg * 8 + (rem & 7);
    return true;
}

struct EpiIn0 {
    const Params* p;
    DI void operator()(f32x4 (&acc)[4][4], int mbase, int nbase, int lr, int lg) const {
        const int cidx = nbase >> 6;
        if (cidx >= 41) return;
        const int b = mbase >> 14;
        if (cidx == 40) {
#pragma unroll
            for (int mi = 0; mi < 4; ++mi)
#pragma unroll
                for (int ni = 0; ni < 3; ++ni)
#pragma unroll
                    for (int j = 0; j < 4; ++j) {
                        const int row = mbase + mi * 16 + lg * 4 + j;
                        p->gates0[(size_t)row * 48 + ni * 16 + lr] = 1.0f / (1.0f + __expf(-acc[mi][ni][j]));
                    }
            return;
        }
        int c6 = -1, g = 0;
        if (cidx >= 16) { c6 = (cidx - 16) >> 2; g = (cidx - 16) & 3; }
        const bool do_rope = (c6 < 0) || c6 == 0 || c6 == 2 || c6 == 4;
        if (do_rope) {
#pragma unroll
            for (int mi = 0; mi < 4; ++mi)
#pragma unroll
                for (int j = 0; j < 4; ++j) {
                    const int s = (mbase + mi * 16 + lg * 4 + j) & (SEQ - 1);
#pragma unroll
                    for (int ni = 0; ni < 2; ++ni) {
                        const float2 cs = p->rope[s * 32 + ni * 16 + lr];
                        const float x1 = acc[mi][ni][j], x2 = acc[mi][ni + 2][j];
                        acc[mi][ni][j] = x1 * cs.x - x2 * cs.y;
                        acc[mi][ni + 2][j] = x2 * cs.x + x1 * cs.y;
                    }
                }
        }
        if (c6 < 0) {
#pragma unroll
            for (int mi = 0; mi < 4; ++mi)
#pragma unroll
                for (int ni = 0; ni < 4; ++ni)
#pragma unroll
                    for (int j = 0; j < 4; ++j) {
                        const int row = mbase + mi * 16 + lg * 4 + j;
                        p->q0[(size_t)row * 1024 + cidx * 64 + ni * 16 + lr] = f2bf(acc[mi][ni][j] * (0.125f * LOG2E));
                    }
        } else if (c6 == 3 || c6 == 5) {
            const int bg = b * 4 + g;
#pragma unroll
            for (int mi = 0; mi < 4; ++mi)
#pragma unroll
                for (int ni = 0; ni < 4; ++ni) {
                    const int s0 = (mbase + mi * 16 + lg * 4) & (SEQ - 1), d = ni * 16 + lr;
                    if (c6 == 3) {
                        *(unsigned*)((unsigned char*)p->vslcT + ((size_t)(bg * 256 + (s0 >> 6)) * 64 + d) * 64 + (s0 & 63)) = pack4_fp8(acc[mi][ni][0], acc[mi][ni][1], acc[mi][ni][2], acc[mi][ni][3]);
                    } else {
                        u32x2 w; w.x = pack2(acc[mi][ni][0], acc[mi][ni][1]); w.y = pack2(acc[mi][ni][2], acc[mi][ni][3]);
                        *(u32x2*)(p->vwinT + ((size_t)bg * 64 + d) * SEQ + s0) = w;
                    }
                }
        } else {
            bf16_t* base = (c6 == 0) ? p->kcin : (c6 == 1) ? p->vcin : (c6 == 2) ? p->kslc : p->kwin;
            const int bg = b * 4 + g;
#pragma unroll
            for (int mi = 0; mi < 4; ++mi)
#pragma unroll
                for (int ni = 0; ni < 4; ++ni)
#pragma unroll
                    for (int j = 0; j < 4; ++j) {
                        const int s = (mbase + mi * 16 + lg * 4 + j) & (SEQ - 1);
                        if (c6 == 2) ((unsigned char*)base)[((size_t)bg * SEQ + s) * 64 + ni * 16 + lr] = (unsigned char)(pack4_fp8(acc[mi][ni][j], 0.f, 0.f, 0.f) & 0xffu);
                        else base[((size_t)bg * SEQ + s) * 64 + ni * 16 + lr] = f2bf(acc[mi][ni][j]);
                    }
        }
    }
};
struct EpiIn1 {
    const Params* p;
    DI void operator()(f32x4 (&acc)[4][4], int mbase, int nbase, int lr, int lg) const {
        const int cidx = nbase >> 6;
        if (cidx >= 49) return;
        const int b = mbase >> 14;
        if (cidx == 48) {
            const float fb = p->l1_f_bias[lr];
#pragma unroll
            for (int mi = 0; mi < 4; ++mi)
#pragma unroll
                for (int j = 0; j < 4; ++j) {
                    const int s = (mbase + mi * 16 + lg * 4 + j) & (SEQ - 1);
                    const float z = acc[mi][0][j] + fb;
                    p->cfox[((size_t)(b * 16 + lr)) * SEQ + s] = (fminf(z, 0.f) - log1pf(__expf(-fabsf(z)))) * LOG2E;
                }
            return;
        }
        if (cidx < 16) {
#pragma unroll
            for (int mi = 0; mi < 4; ++mi)
#pragma unroll
                for (int ni = 0; ni < 4; ++ni)
#pragma unroll
                    for (int j = 0; j < 4; ++j) {
                        const int row = mbase + mi * 16 + lg * 4 + j;
                        p->q1[(size_t)row * 1024 + cidx * 64 + ni * 16 + lr] = f2bf(acc[mi][ni][j] * (0.125f * LOG2E));
                    }
        } else if (cidx < 32) {
            const int bh = b * 16 + (cidx - 16);
#pragma unroll
            for (int mi = 0; mi < 4; ++mi)
#pragma unroll
                for (int ni = 0; ni < 4; ++ni)
#pragma unroll
                    for (int j = 0; j < 4; ++j) {
                        const int s = (mbase + mi * 16 + lg * 4 + j) & (SEQ - 1);
                        p->k1[((size_t)bh * SEQ + s) * 64 + ni * 16 + lr] = f2bf(acc[mi][ni][j]);
                    }
        } else {
            const int bh = b * 16 + (cidx - 32);
#pragma unroll
            for (int mi = 0; mi < 4; ++mi)
#pragma unroll
                for (int ni = 0; ni < 4; ++ni) {
                    const int s0 = (mbase + mi * 16 + lg * 4) & (SEQ - 1), d = ni * 16 + lr;
                    u32x2 w; w.x = pack2(acc[mi][ni][0], acc[mi][ni][1]); w.y = pack2(acc[mi][ni][2], acc[mi][ni][3]);
                    *(u32x2*)(p->v1T + ((size_t)bh * 64 + d) * SEQ + s0) = w;
                }
        }
    }
};
struct EpiResid {
    const float* res; float* out;
    DI void operator()(f32x4 (&acc)[4][4], int mbase, int nbase, int lr, int lg) const {
#pragma unroll
        for (int mi = 0; mi < 4; ++mi)
#pragma unroll
            for (int ni = 0; ni < 4; ++ni)
#pragma unroll
                for (int j = 0; j < 4; ++j) {
                    const size_t o = (size_t)(mbase + mi * 16 + lg * 4 + j) * 1024 + nbase + ni * 16 + lr;
                    out[o] = res[o] + acc[mi][ni][j];
                }
    }
};
struct EpiF32 {
    float* out; int ld;
    DI void operator()(f32x4 (&acc)[4][4], int mbase, int nbase, int lr, int lg) const {
#pragma unroll
        for (int mi = 0; mi < 4; ++mi)
#pragma unroll
            for (int ni = 0; ni < 4; ++ni)
#pragma unroll
                for (int j = 0; j < 4; ++j) out[(size_t)(mbase + mi * 16 + lg * 4 + j) * ld + nbase + ni * 16 + lr] = acc[mi][ni][j];
    }
};
struct EpiBf16 {
    bf16_t* out; int ld;
    DI void operator()(f32x4 (&acc)[4][4], int mbase, int nbase, int lr, int lg) const {
#pragma unroll
        for (int mi = 0; mi < 4; ++mi)
#pragma unroll
            for (int ni = 0; ni < 4; ++ni)
#pragma unroll
                for (int j = 0; j < 4; ++j) out[(size_t)(mbase + mi * 16 + lg * 4 + j) * ld + nbase + ni * 16 + lr] = f2bf(acc[mi][ni][j]);
    }
};
struct EpiCmp1 {
    bf16_t* out; const float* bias;
    DI void operator()(f32x4 (&acc)[4][4], int mbase, int nbase, int lr, int lg) const {
#pragma unroll
        for (int ni = 0; ni < 4; ++ni) {
            float bv = 0.f;
#pragma unroll
            for (int ksl = 0; ksl < 16; ++ksl) bv += bias[ksl * 1024 + nbase + ni * 16 + lr];
#pragma unroll
            for (int mi = 0; mi < 4; ++mi)
#pragma unroll
                for (int j = 0; j < 4; ++j) out[(size_t)(mbase + mi * 16 + lg * 4 + j) * 128 + nbase + ni * 16 + lr] = f2bf(gelu_tanh(acc[mi][ni][j] + bv));
        }
    }
};
struct EpiCmp2 {
    bf16_t* kc; bf16_t* vt; int kv;
    DI void operator()(f32x4 (&acc)[4][4], int mbase, int nbase, int lr, int lg) const {
        if (nbase >= 64) return;
#pragma unroll
        for (int mi = 0; mi < 4; ++mi)
#pragma unroll
            for (int ni = 0; ni < 4; ++ni) {
                const int c0 = mbase + mi * 16 + lg * 4, d = ni * 16 + lr;
                float v[4];
#pragma unroll
                for (int j = 0; j < 4; ++j) v[j] = (c0 + j < 1023) ? acc[mi][ni][j] : 0.f;
                if (kv == 0) {
#pragma unroll
                    for (int j = 0; j < 4; ++j) kc[(size_t)(c0 + j) * 64 + d] = f2bf(v[j]);
                } else {
                    u32x2 w; w.x = pack2(v[0], v[1]); w.y = pack2(v[2], v[3]);
                    *(u32x2*)(vt + (size_t)d * 1024 + c0) = w;
                }
            }
    }
};

DI void transpose_cvt(const float* __restrict__ in, int K, int N, int Npad, bf16_t* __restrict__ out, int gtid, int gsz) {
    const int total = Npad * (K >> 3);
    for (int idx = gtid; idx < total; idx += gsz) {
        const int n = idx % Npad, k8 = idx / Npad;
        u32x4 w = (u32x4){0u, 0u, 0u, 0u};
        if (n < N) {
            float v[8];
#pragma unroll
            for (int i = 0; i < 8; ++i) v[i] = in[(size_t)(k8 * 8 + i) * N + n];
            w.x = pack2(v[0], v[1]); w.y = pack2(v[2], v[3]); w.z = pack2(v[4], v[5]); w.w = pack2(v[6], v[7]);
        }
        *(u32x4*)(out + (size_t)n * K + k8 * 8) = w;
    }
}
DI void convert_bf16(const float* __restrict__ in, bf16_t* __restrict__ out, size_t n, int gtid, int gsz) {
    const size_t n8 = n >> 3;
    for (size_t i = gtid; i < n8; i += gsz) {
        const f32x4 a = *(const f32x4*)(in + i * 8), b = *(const f32x4*)(in + i * 8 + 4);
        u32x4 w; w.x = pack2(a[0], a[1]); w.y = pack2(a[2], a[3]); w.z = pack2(b[0], b[1]); w.w = pack2(b[2], b[3]);
        *(u32x4*)(out + i * 8) = w;
    }
}
constexpr float U8_SCALE = 512.0f, X8_SCALE = 16.0f;
DI unsigned pack4_i8(float a, float b, float c, float d, float scale) {
    int v0 = (int)__builtin_rintf(a * scale), v1 = (int)__builtin_rintf(b * scale), v2 = (int)__builtin_rintf(c * scale), v3 = (int)__builtin_rintf(d * scale);
    v0 = v0 < -127 ? -127 : (v0 > 127 ? 127 : v0); v1 = v1 < -127 ? -127 : (v1 > 127 ? 127 : v1);
    v2 = v2 < -127 ? -127 : (v2 > 127 ? 127 : v2); v3 = v3 < -127 ? -127 : (v3 > 127 ? 127 : v3);
    return (unsigned)(v0 & 255) | ((unsigned)(v1 & 255) << 8) | ((unsigned)(v2 & 255) << 16) | ((unsigned)v3 << 24);
}
DI void convert_tables_fp8(const float* __restrict__ u, const float* __restrict__ v, unsigned char* __restrict__ u8, unsigned char* __restrict__ v8s, int gtid, int gsz) {
    for (int idx = gtid; idx < 16384 * 64; idx += gsz) {
        const int e = idx >> 6, c = idx & 63;
        const float* up = u + (size_t)e * 1024 + c * 16;
        const float* vp = v + (size_t)e * 1024 + c * 16;
        u32x4 wu, wv;
#pragma unroll
        for (int q = 0; q < 4; ++q) {
            const f32x4 a = *(const f32x4*)(up + 4 * q), b = *(const f32x4*)(vp + 4 * q) * FP8_SCALE;
            wu[q] = pack4_i8(a[0], a[1], a[2], a[3], U8_SCALE); wv[q] = pack4_fp8(b[0], b[1], b[2], b[3]);
        }
        *(u32x4*)(u8 + (size_t)e * 1024 + c * 16) = wu;
        *(u32x4*)(v8s + ((size_t)(c >> 3) * 16384 + e) * 128 + (c & 7) * 16) = wv;
    }
}
DI void rmsnorm_rows(const float* in, const float* gain, bf16_t* outb, float* outf) {
    const int lane = threadIdx.x & 63, gw = (blockIdx.x * blockDim.x + threadIdx.x) >> 6, nw = (gridDim.x * blockDim.x) >> 6;
    for (int row = gw; row < NTOK; row += nw) {
        const float* xr = in + (size_t)row * 1024;
        f32x4 v[4]; float ss = 0.f;
#pragma unroll
        for (int i = 0; i < 4; ++i) { v[i] = *(const f32x4*)(xr + i * 256 + lane * 4); ss += v[i][0] * v[i][0] + v[i][1] * v[i][1] + v[i][2] * v[i][2] + v[i][3] * v[i][3]; }
#pragma unroll
        for (int off = 32; off >= 1; off >>= 1) ss += __shfl_xor(ss, off);
        const float rs = rsqrtf(ss * (1.0f / 1024.0f) + 1e-6f);
#pragma unroll
        for (int i = 0; i < 4; ++i) {
            const f32x4 g = *(const f32x4*)(gain + i * 256 + lane * 4);
            const f32x4 y = v[i] * rs * g;
            if (outb) { u32x2 w; w.x = pack2(y[0], y[1]); w.y = pack2(y[2], y[3]); *(u32x2*)(outb + (size_t)row * 1024 + i * 256 + lane * 4) = w; }
            else *(f32x4*)(outf + (size_t)row * 1024 + i * 256 + lane * 4) = y;
        }
    }
}

DI void rmsnorm_rows_q8(const float* in, const float* gain, bf16_t* outb, unsigned char* out8) {
    const int lane = threadIdx.x & 63, gw = (blockIdx.x * blockDim.x + threadIdx.x) >> 6, nw = (gridDim.x * blockDim.x) >> 6;
    for (int row = gw; row < NTOK; row += nw) {
        const float* xr = in + (size_t)row * 1024;
        f32x4 v[4]; float ss = 0.f;
#pragma unroll
        for (int i = 0; i < 4; ++i) { v[i] = *(const f32x4*)(xr + i * 256 + lane * 4); ss += v[i][0] * v[i][0] + v[i][1] * v[i][1] + v[i][2] * v[i][2] + v[i][3] * v[i][3]; }
#pragma unroll
        for (int off = 32; off >= 1; off >>= 1) ss += __shfl_xor(ss, off);
        const float rs = rsqrtf(ss * (1.0f / 1024.0f) + 1e-6f);
#pragma unroll
        for (int i = 0; i < 4; ++i) {
            const f32x4 g = *(const f32x4*)(gain + i * 256 + lane * 4);
            const f32x4 y = v[i] * rs * g;
            u32x2 w; w.x = pack2(y[0], y[1]); w.y = pack2(y[2], y[3]);
            *(u32x2*)(outb + (size_t)row * 1024 + i * 256 + lane * 4) = w;
            *(unsigned*)(out8 + (size_t)row * 1024 + i * 256 + lane * 4) = pack4_i8(y[0], y[1], y[2], y[3], X8_SCALE);
        }
    }
}
template <int MODE>
DI void rmsnorm_pipe(const float* in, const float* gain, bf16_t* outb, float* outf, unsigned char* out8) {
    const int lane = threadIdx.x & 63, gw = (blockIdx.x * blockDim.x + threadIdx.x) >> 6, nw = (gridDim.x * blockDim.x) >> 6;
    f32x4 g[4];
#pragma unroll
    for (int i = 0; i < 4; ++i) g[i] = *(const f32x4*)(gain + i * 256 + lane * 4);
    int row = gw;
    f32x4 nv[4];
#pragma unroll
    for (int i = 0; i < 4; ++i) nv[i] = (f32x4){0.f, 0.f, 0.f, 0.f};
    if (row < NTOK) {
#pragma unroll
        for (int i = 0; i < 4; ++i) nv[i] = *(const f32x4*)(in + (size_t)row * 1024 + i * 256 + lane * 4);
    }
    for (; row < NTOK; row += nw) {
        f32x4 v[4];
#pragma unroll
        for (int i = 0; i < 4; ++i) v[i] = nv[i];
        if (row + nw < NTOK) {
#pragma unroll
            for (int i = 0; i < 4; ++i) nv[i] = *(const f32x4*)(in + (size_t)(row + nw) * 1024 + i * 256 + lane * 4);
        }
        float ss = 0.f;
#pragma unroll
        for (int i = 0; i < 4; ++i) ss += v[i][0] * v[i][0] + v[i][1] * v[i][1] + v[i][2] * v[i][2] + v[i][3] * v[i][3];
        ss = octet_sum(ss);
        ss = xrow16_sum(dppf<0x128>(ss) + ss);
        const float rs = rsqrtf(ss * (1.0f / 1024.0f) + 1e-6f);
#pragma unroll
        for (int i = 0; i < 4; ++i) {
            const f32x4 y = v[i] * rs * g[i];
            if (MODE == 2) *(f32x4*)(outf + (size_t)row * 1024 + i * 256 + lane * 4) = y;
            else { u32x2 w; w.x = pack2(y[0], y[1]); w.y = pack2(y[2], y[3]); *(u32x2*)(outb + (size_t)row * 1024 + i * 256 + lane * 4) = w; }
            if (MODE == 1) *(unsigned*)(out8 + (size_t)row * 1024 + i * 256 + lane * 4) = pack4_i8(y[0], y[1], y[2], y[3], X8_SCALE);
        }
    }
}
DI void phase_prologue(const Params& p) {
    const int gtid = blockIdx.x * blockDim.x + threadIdx.x, gsz = gridDim.x * blockDim.x;
    for (int idx = gtid; idx < SEQ * 32; idx += gsz) {
        const int s = idx >> 5, i = idx & 31;
        const float inv = powf(10000.0f, -(float)i / 32.0f);
        const float ang = (float)s * inv;
        float sn, cs; sincosf(ang, &sn, &cs);
        p.rope[idx] = make_float2(cs, sn);
    }
    transpose_cvt(p.l0_w_in, 1024, NSA_N, NSA_NP, p.wt_in0, gtid, gsz);
    transpose_cvt(p.l0_w_out, 1024, 1024, 1024, p.wt_out0, gtid, gsz);
    transpose_cvt(p.l1_w_in, 1024, FOX_N, FOX_NP, p.wt_in1, gtid, gsz);
    transpose_cvt(p.l1_w_out, 1024, 1024, 1024, p.wt_out1, gtid, gsz);
    for (int kv = 0; kv < 2; ++kv)
        for (int g = 0; g < 4; ++g) {
            transpose_cvt((kv ? p.l0_w1_v : p.l0_w1_k) + (size_t)g * 2048 * 128, 2048, 128, 128, p.w1t + (size_t)(kv * 4 + g) * 128 * 2048, gtid, gsz);
            transpose_cvt((kv ? p.l0_w2_v : p.l0_w2_k) + (size_t)g * 128 * 64, 128, 64, 128, p.w2t + (size_t)(kv * 4 + g) * 128 * 128, gtid, gsz);
        }
    convert_bf16(p.l0_wq, p.wq0b, (size_t)1024 * 2048, gtid, gsz);
    convert_bf16(p.l1_wq, p.wq1b, (size_t)1024 * 2048, gtid, gsz);
    convert_bf16(p.l0_keys, p.keys0b, (size_t)16 * 128 * 128, gtid, gsz);
    convert_bf16(p.l1_keys, p.keys1b, (size_t)16 * 128 * 128, gtid, gsz);
    convert_tables_fp8(p.l0_u, p.l0_v, p.u8, p.v8s, gtid, gsz);
    {
        const int lane = threadIdx.x & 63, gw = gtid >> 6, nw = gsz >> 6;
        for (int item = gw; item < 16 * 16; item += nw) {
            const int out = item >> 4, ksl = item & 15, kv = out >> 3, g = (out >> 1) & 3, h = (out & 1) * 64 + lane;
            const float* pe = (kv ? p.l0_pe_v : p.l0_pe_k) + g * 2048 + ksl * 128;
            const float* w1 = (kv ? p.l0_w1_v : p.l0_w1_k) + (size_t)g * 2048 * 128 + (size_t)ksl * 128 * 128 + h;
            float s0 = 0.f, s1 = 0.f, s2 = 0.f, s3 = 0.f;
            for (int kk = 0; kk < 128; kk += 4) {
                s0 += pe[kk] * w1[(size_t)kk * 128]; s1 += pe[kk + 1] * w1[(size_t)(kk + 1) * 128];
                s2 += pe[kk + 2] * w1[(size_t)(kk + 2) * 128]; s3 += pe[kk + 3] * w1[(size_t)(kk + 3) * 128];
            }
            p.b1[ksl * 1024 + (kv * 4 + g) * 128 + h] = (s0 + s1) + (s2 + s3);
        }
    }
    rmsnorm_pipe<0>(p.x, p.l0_attn_norm, p.xn, nullptr, nullptr);
}

DI void phase_gemm_in0(const Params& p, char* smem) {
    bf16_t* As = (bf16_t*)smem; bf16_t* Bs = As + 128 * GS;
    EpiIn0 e0{&p};
    { int tm, tn; for (int it = 0; gemm_order(it, 10, tm, tn); ++it) gemm_tile_w(p.xn, 1024, p.wt_in0, 1024, 1024, tm * 128, tn * 256, e0, As, Bs); }
    for (int t = blockIdx.x; t < NTOK / 128; t += gridDim.x) gemm_tile(p.xn, 1024, p.wt_in0, 1024, 1024, t * 128, 2560, e0, As, Bs);
    for (int t = blockIdx.x; t < 256; t += gridDim.x) {
        const int layer = t >> 7, hp = (t >> 3) & 15, nt = t & 7;
        EpiBf16 e{(layer ? p.weff1 : p.weff0) + (size_t)hp * 128 * 1024, 1024};
        gemm_tile((layer ? p.keys1b : p.keys0b) + (size_t)hp * 16384, 128, (layer ? p.wq1b : p.wq0b) + hp * 128, 2048, 128, 0, nt * 128, e, As, Bs);
    }
}
DI void phase_gemm_in1(const Params& p, char* smem) {
    bf16_t* As = (bf16_t*)smem; bf16_t* Bs = As + 128 * GS;
    EpiIn1 e1{&p};
    int tm, tn; for (int it = 0; gemm_order(it, 12, tm, tn); ++it) gemm_tile_w(p.xn, 1024, p.wt_in1, 1024, 1024, tm * 128, tn * 256, e1, As, Bs);
    for (int t = blockIdx.x; t < NTOK / 128; t += gridDim.x) gemm_tile(p.xn, 1024, p.wt_in1, 1024, 1024, t * 128, 3072, e1, As, Bs);
}
DI void phase_gemm_out(const bf16_t* o, const bf16_t* wt, const float* res, float* out, char* smem) {
    bf16_t* As = (bf16_t*)smem; bf16_t* Bs = As + 128 * GS;
    EpiResid e{res, out};
    int tm, tn; for (int it = 0; gemm_order(it, 4, tm, tn); ++it) gemm_tile_w(o, 1024, wt, 1024, 1024, tm * 128, tn * 256, e, As, Bs);
}
DI void phase_gemm_scores(const Params& p, const bf16_t* weff, char* smem) {
    bf16_t* As = (bf16_t*)smem; bf16_t* Bs = As + 128 * GS;
    EpiF32 e{p.scores, 2048};
    int tm, tn; for (int it = 0; gemm_order(it, 8, tm, tn); ++it) gemm_tile_w(p.xn, 1024, weff, 1024, 1024, tm * 128, tn * 256, e, As, Bs);
}
DI void phase_cmp1(const Params& p, char* smem) {
    bf16_t* As = (bf16_t*)smem; bf16_t* Bs = As + 128 * GS;
    for (int t = blockIdx.x; t < 128; t += gridDim.x) {
        const int q = t >> 3, mt = t & 7, kv = q >> 3, bg = q & 7, g = bg & 3;
        EpiCmp1 e{p.hid + (size_t)q * 1024 * 128, p.b1 + (kv * 4 + g) * 128};
        gemm_tile((kv ? p.vcin : p.kcin) + (size_t)bg * SEQ * 64, 1024, p.w1t + (size_t)(kv * 4 + g) * 128 * 2048, 2048, 2048, mt * 128, 0, e, As, Bs);
    }
}
DI void phase_cmp2(const Params& p, char* smem) {
    bf16_t* As = (bf16_t*)smem; bf16_t* Bs = As + 128 * GS;
    for (int t = blockIdx.x; t < 128; t += gridDim.x) {
        const int q = t >> 3, mt = t & 7, kv = q >> 3, bg = q & 7, g = bg & 3;
        EpiCmp2 e{p.kcmp + (size_t)bg * 1024 * 64, p.vcmpT + (size_t)bg * 64 * 1024, kv};
        gemm_tile(p.hid + (size_t)q * 1024 * 128, 128, p.w2t + (size_t)(kv * 4 + g) * 128 * 128, 128, 128, mt * 128, 0, e, As, Bs);
    }
}

constexpr int KS = 72;
DI int crow16(int reg, int hh) { return (reg & 3) + 8 * (reg >> 2) + 4 * hh; }
DI void tile_ld(const bf16_t* __restrict__ g, size_t row_stride, u32x4 (&r)[2]) {
#pragma unroll
    for (int i = 0; i < 2; ++i) { const int id = threadIdx.x + 256 * i; r[i] = *(const u32x4*)(g + (size_t)(id >> 3) * row_stride + (id & 7) * 8); }
}
DI void tile_st(bf16_t* l, const u32x4 (&r)[2]) {
#pragma unroll
    for (int i = 0; i < 2; ++i) { const int id = threadIdx.x + 256 * i; *(u32x4*)(l + (id >> 3) * KS + (id & 7) * 8) = r[i]; }
}
DI void qk_tile(const bf16_t* Ks, const bf16x8 (&qf)[4], f32x16 (&S)[2], int l31, int hh) {
    bf16x8 a[2][4];
#pragma unroll
    for (int kb = 0; kb < 2; ++kb)
#pragma unroll
        for (int ks = 0; ks < 4; ++ks) a[kb][ks] = *(const bf16x8*)(Ks + (32 * kb + l31) * KS + 16 * ks + 8 * hh);
#pragma unroll
    for (int kb = 0; kb < 2; ++kb) {
#pragma unroll
        for (int i = 0; i < 16; ++i) S[kb][i] = 0.f;
#pragma unroll
        for (int ks = 0; ks < 4; ++ks) S[kb] = MFMA32(a[kb][ks], qf[ks], S[kb]);
    }
}
DI void pv_tile(const bf16_t* Vs, const f32x16 (&P)[2], f32x16 (&O)[2], int l31, int hh) {
#pragma unroll
    for (int kb = 0; kb < 2; ++kb) {
        s16x4 lo[2][2], hi[2][2];
#pragma unroll
        for (int s = 0; s < 2; ++s)
#pragma unroll
            for (int db = 0; db < 2; ++db) {
                const bf16_t* vp = Vs + (32 * db + l31) * KS + 32 * kb + 16 * s + 4 * hh;
                lo[s][db] = *(const s16x4*)vp; hi[s][db] = *(const s16x4*)(vp + 8);
            }
#pragma unroll
        for (int s = 0; s < 2; ++s) {
            u32x4 pw;
            pw.x = pack2(P[kb][8 * s + 0], P[kb][8 * s + 1]); pw.y = pack2(P[kb][8 * s + 2], P[kb][8 * s + 3]);
            pw.z = pack2(P[kb][8 * s + 4], P[kb][8 * s + 5]); pw.w = pack2(P[kb][8 * s + 6], P[kb][8 * s + 7]);
            const bf16x8 pf = __builtin_bit_cast(bf16x8, pw);
#pragma unroll
            for (int db = 0; db < 2; ++db) {
                const bf16x8 a = __builtin_shufflevector(lo[s][db], hi[s][db], 0, 1, 2, 3, 4, 5, 6, 7);
                O[db] = MFMA32(a, pf, O[db]);
            }
        }
    }
}
DI void softmax_update(f32x16 (&S)[2], f32x16 (&O)[2], float& m, float& l) {
    float mx = NEGINF;
#pragma unroll
    for (int kb = 0; kb < 2; ++kb)
#pragma unroll
        for (int i = 0; i < 16; ++i) mx = fmaxf(mx, S[kb][i]);
    mx = fmaxf(mx, __shfl_xor(mx, 32));
    const float mnew = fmaxf(m, mx);
    const float msafe = (mnew == NEGINF) ? 0.f : mnew;
    const float alpha = __builtin_amdgcn_exp2f(m - msafe);
    float rs = 0.f;
#pragma unroll
    for (int kb = 0; kb < 2; ++kb)
#pragma unroll
        for (int i = 0; i < 16; ++i) { const float pv = __builtin_amdgcn_exp2f(S[kb][i] - msafe); S[kb][i] = pv; rs += pv; }
    l = l * alpha + rs; m = mnew;
#pragma unroll
    for (int db = 0; db < 2; ++db)
#pragma unroll
        for (int i = 0; i < 16; ++i) O[db][i] *= alpha;
}

DI void softmax_update_lazy(f32x16 (&S)[2], f32x16 (&O)[2], float& m, float& l) {
    float mx = NEGINF;
#pragma unroll
    for (int kb = 0; kb < 2; ++kb)
#pragma unroll
        for (int i = 0; i < 16; ++i) mx = fmaxf(mx, S[kb][i]);
    mx = xhalf_max(mx);
    if (__any(mx > m + 8.0f)) {
        const float mnew = fmaxf(m, mx), ms = (mnew == NEGINF) ? 0.f : mnew;
        const float alpha = __builtin_amdgcn_exp2f(m - ms);
        l *= alpha; m = mnew;
#pragma unroll
        for (int db = 0; db < 2; ++db)
#pragma unroll
            for (int i = 0; i < 16; ++i) O[db][i] *= alpha;
    }
    const float msafe = (m == NEGINF) ? 0.f : m;
    float rs = 0.f;
#pragma unroll
    for (int kb = 0; kb < 2; ++kb)
#pragma unroll
        for (int i = 0; i < 16; ++i) { const float pv = __builtin_amdgcn_exp2f(S[kb][i] - msafe); S[kb][i] = pv; rs += pv; }
    l += rs;
}
DI void phase_fox(const Params& p, char* smem) {
    bf16_t* T2 = (bf16_t*)smem;
    float* cks = (float*)(T2 + 4 * 64 * KS); int* ktmin = (int*)(cks + 128);
    const int tid = threadIdx.x, lane = tid & 63, wid = tid >> 6, l31 = lane & 31, hh = lane >> 5;
    for (int u = blockIdx.x; u < 4096; u += gridDim.x) {
        const int qt = 127 - (u >> 5), bh = u & 31, b = bh >> 4, h = bh & 15;
        const int t0 = qt * 128, tw = t0 + 32 * wid, tq = tw + l31;
        const bf16_t* Kg = p.k1 + (size_t)bh * SEQ * 64;
        const bf16_t* Vg = p.v1T + (size_t)bh * 64 * SEQ;
        const float* cg = p.cfox + (size_t)bh * SEQ;
        const int ntile = 2 * qt + 2;
        __syncthreads();
        if (tid == 0) *ktmin = ntile - 1;
        __syncthreads();
        {
            const float bnd = 2.0f * sqrtf(__uint_as_float(p.nrm[bh * 2]) * __uint_as_float(p.nrm[bh * 2 + 1])) + 160.0f;
            if (tid < ntile && (cg[t0] - cg[64 * tid + 63]) >= -bnd) atomicMin(ktmin, tid);
        }
        __syncthreads();
        const int kt_start = *ktmin;
        bf16x8 qf[4];
#pragma unroll
        for (int ks = 0; ks < 4; ++ks) qf[ks] = *(const bf16x8*)(p.q1 + ((size_t)(b * SEQ + tq)) * 1024 + h * 64 + 16 * ks + 8 * hh);
        const float cq = cg[tq];
        f32x16 O[2];
#pragma unroll
        for (int db = 0; db < 2; ++db)
#pragma unroll
            for (int i = 0; i < 16; ++i) O[db][i] = 0.f;
        float m = NEGINF, l = 0.f;
        const int s_hi = qt, s_lo = kt_start >> 1;
        u32x4 rk[2][2], rv[2][2]; float rc = 0.f;
#pragma unroll
        for (int q = 0; q < 2; ++q) { tile_ld(Kg + (size_t)(2 * s_hi + q) * 64 * 64, 64, rk[q]); tile_ld(Vg + (2 * s_hi + q) * 64, SEQ, rv[q]); }
        if (tid < 128) rc = cg[2 * s_hi * 64 + tid];
        for (int st = s_hi; st >= s_lo; --st) {
            __syncthreads();
#pragma unroll
            for (int q = 0; q < 2; ++q) { tile_st(T2 + q * 2 * 64 * KS, rk[q]); tile_st(T2 + q * 2 * 64 * KS + 64 * KS, rv[q]); }
            if (tid < 128) cks[tid] = rc;
            __syncthreads();
            if (st - 1 >= s_lo) {
#pragma unroll
                for (int q = 0; q < 2; ++q) { tile_ld(Kg + (size_t)(2 * (st - 1) + q) * 64 * 64, 64, rk[q]); tile_ld(Vg + (2 * (st - 1) + q) * 64, SEQ, rv[q]); }
                if (tid < 128) rc = cg[2 * (st - 1) * 64 + tid];
            }
#pragma unroll
            for (int qq = 0; qq < 2; ++qq) {
                const int q = 1 - qq, kt = 2 * st + q, k0 = kt * 64;
                if (kt < kt_start || k0 > tw + 31) continue;
                const bf16_t* Ks = T2 + q * 2 * 64 * KS; const bf16_t* Vs = Ks + 64 * KS;
                f32x16 S[2];
#pragma unroll
                for (int kb = 0; kb < 2; ++kb)
#pragma unroll
                    for (int g4 = 0; g4 < 4; ++g4) {
                        const f32x4 ck = *(const f32x4*)(cks + 64 * q + 32 * kb + 8 * g4 + 4 * hh);
#pragma unroll
                        for (int j = 0; j < 4; ++j) S[kb][4 * g4 + j] = cq - ck[j];
                    }
                {
                    bf16x8 a[2][4];
#pragma unroll
                    for (int kb = 0; kb < 2; ++kb)
#pragma unroll
                        for (int ks = 0; ks < 4; ++ks) a[kb][ks] = *(const bf16x8*)(Ks + (32 * kb + l31) * KS + 16 * ks + 8 * hh);
#pragma unroll
                    for (int kb = 0; kb < 2; ++kb)
#pragma unroll
                        for (int ks = 0; ks < 4; ++ks) S[kb] = MFMA32(a[kb][ks], qf[ks], S[kb]);
                }
                if (k0 + 63 > tw) {
#pragma unroll
                    for (int kb = 0; kb < 2; ++kb)
#pragma unroll
                        for (int i = 0; i < 16; ++i) { const int key = k0 + 32 * kb + crow16(i, hh); S[kb][i] = (key <= tq) ? S[kb][i] : NEGINF; }
                }
                softmax_update_lazy(S, O, m, l);
                pv_tile(Vs, S, O, l31, hh);
            }
        }
        l = xhalf_sum(l);
        const float inv = 1.0f / l;
        bf16_t* op = p.o1 + ((size_t)(b * SEQ + tq)) * 1024 + h * 64;
#pragma unroll
        for (int db = 0; db < 2; ++db)
#pragma unroll
            for (int g4 = 0; g4 < 4; ++g4) {
                u32x2 w; w.x = pack2(O[db][4 * g4] * inv, O[db][4 * g4 + 1] * inv); w.y = pack2(O[db][4 * g4 + 2] * inv, O[db][4 * g4 + 3] * inv);
                *(u32x2*)(op + 32 * db + 8 * g4 + 4 * hh) = w;
            }
    }
}

constexpr int IST = 257;
DI unsigned octet_max_u32(unsigned v) {
    v = max(v, (unsigned)__builtin_amdgcn_update_dpp(0, (int)v, 0xB1, 0xF, 0xF, true));
    v = max(v, (unsigned)__builtin_amdgcn_update_dpp(0, (int)v, 0x4E, 0xF, 0xF, true));
    v = max(v, (unsigned)__builtin_amdgcn_update_dpp(0, (int)v, 0x141, 0xF, 0xF, true));
    return v;
}
DI void phase_nsa_a(const Params& p, char* smem) {
    bf16_t* Ks = (bf16_t*)smem; bf16_t* Vs = Ks + 64 * KS; float* imp = (float*)(Vs + 64 * KS);
    const int tid = threadIdx.x, lane = tid & 63, wid = tid >> 6, l31 = lane & 31, hh = lane >> 5;
    for (int u = blockIdx.x; u < 4096; u += gridDim.x) {
        const int tile = 511 - (u >> 3), bg = u & 7, b = bg >> 2, g = bg & 3;
        const int hd = l31 & 3, ql8 = 8 * wid + (l31 >> 2);
        const int t0 = tile * 32, tq = t0 + ql8;
        const size_t tok = (size_t)b * SEQ + tq;
        bf16x8 qf[4];
#pragma unroll
        for (int ks = 0; ks < 4; ++ks) qf[ks] = *(const bf16x8*)(p.q0 + tok * 1024 + (g * 4 + hd) * 64 + 16 * ks + 8 * hh);
        const bf16_t* Kc = p.kcmp + (size_t)bg * 1024 * 64;
        const bf16_t* Vc = p.vcmpT + (size_t)bg * 64 * 1024;
        const int ntc = ((t0 >> 4) >> 6) + 1;
        const int call = (t0 - 31) >> 4;
        float m = NEGINF, l = 0.f;
        u32x4 rk[2], rv[2];
        tile_ld(Kc, 64, rk);
        for (int kt = 0; kt < ntc; ++kt) {
            __syncthreads();
            tile_st(Ks, rk);
            __syncthreads();
            if (kt + 1 < ntc) tile_ld(Kc + (size_t)(kt + 1) * 64 * 64, 64, rk);
            f32x16 S[2];
            qk_tile(Ks, qf, S, l31, hh);
            if (kt * 64 + 63 > call) {
#pragma unroll
                for (int kb = 0; kb < 2; ++kb)
#pragma unroll
                    for (int i = 0; i < 16; ++i) { const int c = kt * 64 + 32 * kb + crow16(i, hh); S[kb][i] = (16 * c + 31 <= tq) ? S[kb][i] : NEGINF; }
            }
            float mx = NEGINF;
#pragma unroll
            for (int kb = 0; kb < 2; ++kb)
#pragma unroll
                for (int i = 0; i < 16; ++i) mx = fmaxf(mx, S[kb][i]);
            mx = fmaxf(mx, __shfl_xor(mx, 32));
            if (__any(mx > m + 8.0f)) { const float mnew = fmaxf(m, mx), ms = (mnew == NEGINF) ? 0.f : mnew; l *= __builtin_amdgcn_exp2f(m - ms); m = mnew; }
            const float msafe = (m == NEGINF) ? 0.f : m;
            float rs = 0.f;
#pragma unroll
            for (int kb = 0; kb < 2; ++kb)
#pragma unroll
                for (int i = 0; i < 16; ++i) rs += __builtin_amdgcn_exp2f(S[kb][i] - msafe);
            l += rs;
        }
        l += __shfl_xor(l, 32);
        const float mfin = (m == NEGINF) ? 0.f : m, invl = (l > 0.f) ? 1.0f / l : 0.f;
        __syncthreads();
        f32x16 O[2];
#pragma unroll
        for (int db = 0; db < 2; ++db)
#pragma unroll
            for (int i = 0; i < 16; ++i) O[db][i] = 0.f;
        float carry = 0.f;
        tile_ld(Kc, 64, rk); tile_ld(Vc, 1024, rv);
        for (int kt = 0; kt < ntc; ++kt) {
            __syncthreads();
            tile_st(Ks, rk); tile_st(Vs, rv);
            __syncthreads();
            if (kt + 1 < ntc) { tile_ld(Kc + (size_t)(kt + 1) * 64 * 64, 64, rk); tile_ld(Vc + (kt + 1) * 64, 1024, rv); }
            f32x16 S[2];
            qk_tile(Ks, qf, S, l31, hh);
            if (kt * 64 + 63 > call) {
#pragma unroll
                for (int kb = 0; kb < 2; ++kb)
#pragma unroll
                    for (int i = 0; i < 16; ++i) { const int c = kt * 64 + 32 * kb + crow16(i, hh); S[kb][i] = (16 * c + 31 <= tq) ? S[kb][i] : NEGINF; }
            }
#pragma unroll
            for (int kb = 0; kb < 2; ++kb)
#pragma unroll
                for (int i = 0; i < 16; ++i) S[kb][i] = __builtin_amdgcn_exp2f(S[kb][i] - mfin) * invl;
            float A[2][4], P[2][4];
#pragma unroll
            for (int kb = 0; kb < 2; ++kb)
#pragma unroll
                for (int g4 = 0; g4 < 4; ++g4) {
                    float sp = 0.5f * S[kb][4 * g4 + 3];
                    float a = (S[kb][4 * g4] + S[kb][4 * g4 + 1]) + (S[kb][4 * g4 + 2] + sp);
                    a += __builtin_bit_cast(float, __builtin_amdgcn_update_dpp(0, __builtin_bit_cast(int, a), 0xB1, 0xF, 0xF, true));
                    a += __builtin_bit_cast(float, __builtin_amdgcn_update_dpp(0, __builtin_bit_cast(int, a), 0x4E, 0xF, 0xF, true));
                    sp += __builtin_bit_cast(float, __builtin_amdgcn_update_dpp(0, __builtin_bit_cast(int, sp), 0xB1, 0xF, 0xF, true));
                    sp += __builtin_bit_cast(float, __builtin_amdgcn_update_dpp(0, __builtin_bit_cast(int, sp), 0x4E, 0xF, 0xF, true));
                    const auto t = __builtin_amdgcn_permlane32_swap(__float_as_uint(sp), __float_as_uint(sp), false, false);
                    A[kb][g4] = a; P[kb][g4] = (__uint_as_float(t[0]) + __uint_as_float(t[1])) - sp;
                }
#pragma unroll
            for (int kb = 0; kb < 2; ++kb)
#pragma unroll
                for (int g4 = 0; g4 < 4; ++g4) {
                    const float prev = (g4 > 0) ? P[kb][g4 - 1] : (kb > 0 ? P[0][3] : carry);
                    const float v = A[kb][g4] + (hh ? P[kb][g4] : prev);
                    if (hd == 0) imp[ql8 * IST + 16 * kt + 8 * kb + 2 * g4 + hh] = v;
                }
            carry = P[1][3];
            pv_tile(Vs, S, O, l31, hh);
        }
        __syncthreads();
        {
            const int ql = lane >> 3, sub = lane & 7, q = 8 * wid + ql, cur = t0 >> 6, imax = cur >> 3;
            unsigned k[32];
#pragma unroll
            for (int i = 0; i < 32; ++i) {
                k[i] = 0u;
                if (i <= imax) {
                    const int j = sub + 8 * i;
                    const float v = imp[q * IST + j];
                    const bool forced = (j == 0) | (j == cur) | (j == cur - 1);
                    const float val = forced ? 1.0e4f : ((j <= cur) ? v : -1.0f);
                    k[i] = (ordf(val) & 0xffffff00u) | (unsigned)(255 - j);
                }
            }
            int s0 = 255, s1 = 255;
            for (int r = 0; r < 16; ++r) {
                unsigned best = 0u;
#pragma unroll
                for (int i = 0; i < 32; ++i) if (i <= imax) best = max(best, k[i]);
                best = octet_max_u32(best);
                const int jw = 255 - (int)(best & 255u);
                if (r == sub) s0 = jw;
                if (r == sub + 8) s1 = jw;
#pragma unroll
                for (int i = 0; i < 32; ++i) if (i <= imax) k[i] = (k[i] == best) ? 0u : k[i];
            }
            int* sp = p.sel + (((size_t)b * SEQ + t0 + q) * 4 + g) * 16;
            sp[sub] = s0; sp[8 + sub] = s1;
        }
        __syncthreads();
        float* ob = imp + (wid * 32 + l31) * 64;
        {
            const float gc = p.gates0[tok * 48 + g * 4 + hd];
#pragma unroll
            for (int db = 0; db < 2; ++db)
#pragma unroll
                for (int g4 = 0; g4 < 4; ++g4)
                    *(f32x4*)(ob + 32 * db + 8 * g4 + 4 * hh) = (f32x4){O[db][4 * g4] * gc, O[db][4 * g4 + 1] * gc, O[db][4 * g4 + 2] * gc, O[db][4 * g4 + 3] * gc};
        }
        const bf16_t* Kw = p.kwin + (size_t)bg * SEQ * 64;
        const bf16_t* Vw = p.vwinT + (size_t)bg * 64 * SEQ;
        const int lo = (t0 - 511) > 0 ? (t0 - 511) : 0;
        const int kt_lo = lo >> 6, kt_hi = (t0 + 31) >> 6;
#pragma unroll
        for (int db = 0; db < 2; ++db)
#pragma unroll
            for (int i = 0; i < 16; ++i) O[db][i] = 0.f;
        m = NEGINF; l = 0.f;
        tile_ld(Kw + (size_t)kt_hi * 64 * 64, 64, rk); tile_ld(Vw + kt_hi * 64, SEQ, rv);
        for (int kt = kt_hi; kt >= kt_lo; --kt) {
            __syncthreads();
            tile_st(Ks, rk); tile_st(Vs, rv);
            __syncthreads();
            if (kt - 1 >= kt_lo) { tile_ld(Kw + (size_t)(kt - 1) * 64 * 64, 64, rk); tile_ld(Vw + (kt - 1) * 64, SEQ, rv); }
            f32x16 S[2];
            qk_tile(Ks, qf, S, l31, hh);
            if (!(kt * 64 + 63 <= t0 && kt * 64 > t0 + 31 - 512)) {
#pragma unroll
                for (int kb = 0; kb < 2; ++kb)
#pragma unroll
                    for (int i = 0; i < 16; ++i) {
                        const int key = kt * 64 + 32 * kb + crow16(i, hh);
                        S[kb][i] = (key <= tq && key > tq - 512) ? S[kb][i] : NEGINF;
                    }
            }
            softmax_update_lazy(S, O, m, l);
            pv_tile(Vs, S, O, l31, hh);
        }
        l += __shfl_xor(l, 32);
        {
            const float gw = p.gates0[tok * 48 + 32 + g * 4 + hd] / l;
            bf16_t* op = p.o0 + tok * 1024 + (g * 4 + hd) * 64;
#pragma unroll
            for (int db = 0; db < 2; ++db)
#pragma unroll
                for (int g4 = 0; g4 < 4; ++g4) {
                    const f32x4 oc = *(const f32x4*)(ob + 32 * db + 8 * g4 + 4 * hh);
                    u32x2 w;
                    w.x = pack2(oc[0] + O[db][4 * g4] * gw, oc[1] + O[db][4 * g4 + 1] * gw);
                    w.y = pack2(oc[2] + O[db][4 * g4 + 2] * gw, oc[3] + O[db][4 * g4 + 3] * gw);
                    *(u32x2*)(op + 32 * db + 8 * g4 + 4 * hh) = w;
                }
        }
        __syncthreads();
    }
}

constexpr int NB_ST = 2;
constexpr int NB_TILE = 2 * 64 * KS;
constexpr int OST = 68;
constexpr int NSB_LDS = NB_ST * NB_TILE * 2 + 2048 + 256 + 1024 + 1024 + 256 * OST * 2;
DI void fp8_tile_st(bf16_t* l, const u32x4 r) {
    const int row = threadIdx.x >> 2, c16 = (threadIdx.x & 3) * 16;
    u32x4 w0, w1;
    { const f32x2 a = __builtin_amdgcn_cvt_pk_f32_fp8((int)r.x, false), b = __builtin_amdgcn_cvt_pk_f32_fp8((int)r.x, true); w0.x = pack2(a.x, a.y); w0.y = pack2(b.x, b.y); }
    { const f32x2 a = __builtin_amdgcn_cvt_pk_f32_fp8((int)r.y, false), b = __builtin_amdgcn_cvt_pk_f32_fp8((int)r.y, true); w0.z = pack2(a.x, a.y); w0.w = pack2(b.x, b.y); }
    { const f32x2 a = __builtin_amdgcn_cvt_pk_f32_fp8((int)r.z, false), b = __builtin_amdgcn_cvt_pk_f32_fp8((int)r.z, true); w1.x = pack2(a.x, a.y); w1.y = pack2(b.x, b.y); }
    { const f32x2 a = __builtin_amdgcn_cvt_pk_f32_fp8((int)r.w, false), b = __builtin_amdgcn_cvt_pk_f32_fp8((int)r.w, true); w1.z = pack2(a.x, a.y); w1.w = pack2(b.x, b.y); }
    *(u32x4*)(l + row * KS + c16) = w0; *(u32x4*)(l + row * KS + c16 + 8) = w1;
}
DI int kth_bit4(unsigned mask, int k) {
    unsigned x = mask;
    x = (k >= 1) ? (x & (x - 1u)) : x;
    x = (k >= 2) ? (x & (x - 1u)) : x;
    x = (k >= 3) ? (x & (x - 1u)) : x;
    return __builtin_ctz(x ? x : mask);
}
DI unsigned long long strip4(unsigned long long m, int k) {
    for (int i = 0; i < k; ++i) { m &= m - 1ull; m &= m - 1ull; m &= m - 1ull; m &= m - 1ull; }
    return m;
}
DI unsigned tok4(unsigned long long m) {
    const unsigned t0 = __builtin_ctzll(m); m &= m - 1ull;
    const unsigned t1 = m ? __builtin_ctzll(m) : t0; m &= m - 1ull;
    const unsigned t2 = m ? __builtin_ctzll(m) : t0; m &= m - 1ull;
    const unsigned t3 = m ? __builtin_ctzll(m) : t0;
    return t0 | (t1 << 8) | (t2 << 16) | (t3 << 24);
}
DI void nsa_b_cgroup(const bf16_t* Ks, const bf16_t* Vs, float* Mst, float* Lst, bf16_t* Ost, const bf16x8 q0, const bf16x8 q1, int tloc, bool valid, bool masked, bool diag,
                     int r, int lr, int lg, const bf16x8 ones) {
    const int col = tloc * 4 + r;
    float m = Mst[col];
    f32x4 L; { const float lo = Lst[col]; L = (f32x4){lo, lo, lo, lo}; }
    u32x2 ow[4];
#pragma unroll
    for (int db = 0; db < 4; ++db) ow[db] = *(const u32x2*)(Ost + col * OST + 16 * db + 4 * lg);
    bf16x8 ka[4][2];
#pragma unroll
    for (int kb = 0; kb < 4; ++kb)
#pragma unroll
        for (int ks = 0; ks < 2; ++ks) ka[kb][ks] = *(const bf16x8*)(Ks + (16 * kb + lr) * KS + 32 * ks + 8 * lg);
    f32x4 S[4];
#pragma unroll
    for (int kb = 0; kb < 4; ++kb) {
        S[kb] = MFMA16(ka[kb][0], q0, ((f32x4){0.f, 0.f, 0.f, 0.f}));
        S[kb] = MFMA16(ka[kb][1], q1, S[kb]);
    }
    s16x4 vlo[2][4], vhi[2][4];
#pragma unroll
    for (int s2 = 0; s2 < 2; ++s2)
#pragma unroll
        for (int db = 0; db < 4; ++db) {
            const bf16_t* vq = Vs + (16 * db + lr) * KS + 32 * s2 + 4 * lg;
            vlo[s2][db] = *(const s16x4*)vq; vhi[s2][db] = *(const s16x4*)(vq + 16);
        }
    if (diag) {
#pragma unroll
        for (int kb = 0; kb < 4; ++kb)
#pragma unroll
            for (int jj = 0; jj < 4; ++jj) S[kb][jj] = ((16 * kb + 4 * lg + jj) <= tloc) ? S[kb][jj] : NEGINF;
    }
    float mx = fmaxf(fmaxf(fmaxf(S[0][0], S[0][1]), fmaxf(S[0][2], S[0][3])), fmaxf(fmaxf(S[1][0], S[1][1]), fmaxf(S[1][2], S[1][3])));
    mx = fmaxf(mx, fmaxf(fmaxf(fmaxf(S[2][0], S[2][1]), fmaxf(S[2][2], S[2][3])), fmaxf(fmaxf(S[3][0], S[3][1]), fmaxf(S[3][2], S[3][3]))));
    mx = xrow16_max(mx);
    float alpha = 1.f;
    if (__any(mx > m + 8.0f)) {
        const float mnew = fmaxf(m, mx), ms = (mnew == NEGINF) ? 0.f : mnew;
        alpha = __builtin_amdgcn_exp2f(m - ms);
        m = mnew;
    }
    const float msafe = (m == NEGINF) ? 0.f : m;
    L *= alpha;
    f32x4 O[4];
#pragma unroll
    for (int db = 0; db < 4; ++db) O[db] = (f32x4){bflo(ow[db].x) * alpha, bfhi(ow[db].x) * alpha, bflo(ow[db].y) * alpha, bfhi(ow[db].y) * alpha};
#pragma unroll
    for (int s2 = 0; s2 < 2; ++s2) {
        u32x4 pw;
        pw.x = pack2(__builtin_amdgcn_exp2f(S[2 * s2][0] - msafe), __builtin_amdgcn_exp2f(S[2 * s2][1] - msafe));
        pw.y = pack2(__builtin_amdgcn_exp2f(S[2 * s2][2] - msafe), __builtin_amdgcn_exp2f(S[2 * s2][3] - msafe));
        pw.z = pack2(__builtin_amdgcn_exp2f(S[2 * s2 + 1][0] - msafe), __builtin_amdgcn_exp2f(S[2 * s2 + 1][1] - msafe));
        pw.w = pack2(__builtin_amdgcn_exp2f(S[2 * s2 + 1][2] - msafe), __builtin_amdgcn_exp2f(S[2 * s2 + 1][3] - msafe));
        const bf16x8 pf = __builtin_bit_cast(bf16x8, pw);
        L = MFMA16(ones, pf, L);
#pragma unroll
        for (int db = 0; db < 4; ++db) {
            const bf16x8 a = __builtin_shufflevector(vlo[s2][db], vhi[s2][db], 0, 1, 2, 3, 4, 5, 6, 7);
            O[db] = MFMA16(a, pf, O[db]);
        }
    }
    if (valid) {
#pragma unroll
        for (int db = 0; db < 4; ++db) {
            u32x2 w; w.x = pack2(O[db][0], O[db][1]); w.y = pack2(O[db][2], O[db][3]);
            *(u32x2*)(Ost + col * OST + 16 * db + 4 * lg) = w;
        }
        if (lg == 0) { Mst[col] = m; Lst[col] = L[0]; }
    }
}
DI void phase_nsa_b(const Params& p, char* smem, const int dry_i) {
    const bool dry = dry_i != 0;
    bf16_t* Tl = (bf16_t*)smem;
    unsigned* tmask = (unsigned*)(Tl + NB_ST * NB_TILE);
    float* Mst = (float*)(tmask + 512 + 64);
    float* Lst = Mst + 256;
    bf16_t* Ost = (bf16_t*)(Lst + 256);
    const int tid = threadIdx.x, lane = tid & 63, wid = tid >> 6, lr = lane & 15, lg = lane >> 4, r = lr & 3, tsl = lr >> 2;
    const int grp = blockIdx.x & 7, rank = blockIdx.x >> 3, nrank = (gridDim.x - grp + 7) >> 3;
    const int bg = grp, b = bg >> 2, g = bg & 3;
    const short one = (short)0x3F80;
    const bf16x8 ones = {one, one, one, one, one, one, one, one};
    for (int round = 0; round * nrank < 256; ++round) {
        const int li = (round & 1) ? (round * nrank + (nrank - 1 - rank)) : (round * nrank + rank);
        if (li >= 256) continue;
        const int tile = 255 - li, t0 = tile * 64, cur = tile;
        __syncthreads();
        for (int i = tid; i < 512; i += 256) tmask[i] = 0u;
        Mst[tid] = NEGINF; Lst[tid] = 0.f;
        for (int i = tid; i < 256 * OST * 2 / 16; i += 256) ((u32x4*)Ost)[i] = (u32x4){0u, 0u, 0u, 0u};
        __syncthreads();
        {
            const int tk = tid >> 2;
            const int* sp = p.sel + (((size_t)b * SEQ + t0 + tk) * 4 + g) * 16 + 4 * (tid & 3);
#pragma unroll
            for (int i = 0; i < 4; ++i) atomicOr(&tmask[sp[i] * 2 + (tk >> 5)], 1u << (tk & 31));
        }
        const unsigned char* Kg = (const unsigned char*)p.kslc + (size_t)bg * SEQ * 64;
        const unsigned char* Vg = (const unsigned char*)p.vslcT + (size_t)bg * 256 * 4096;
        const bf16_t* qbase = p.q0 + ((size_t)b * SEQ + t0) * 1024 + (g * 4 + r) * 64 + 8 * lg;
        u32x4 rk0, rv0, rk1, rv1;
        rk0 = *(const u32x4*)(Kg + tid * 16); rv0 = *(const u32x4*)(Vg + tid * 16);
        if (1 <= cur) { rk1 = *(const u32x4*)(Kg + (size_t)4096 + tid * 16); rv1 = *(const u32x4*)(Vg + (size_t)4096 + tid * 16); }
        fp8_tile_st(Tl, rk0); fp8_tile_st(Tl + 64 * KS, rv0);
        if (2 <= cur) { rk0 = *(const u32x4*)(Kg + (size_t)2 * 4096 + tid * 16); rv0 = *(const u32x4*)(Vg + (size_t)2 * 4096 + tid * 16); }
        __syncthreads();
        const int wu = __builtin_amdgcn_readfirstlane(wid);
        unsigned long long mn; int tokn = 0; bf16x8 qn0, qn1;
        {
            const unsigned lo = __builtin_amdgcn_readfirstlane(tmask[0]), hi = __builtin_amdgcn_readfirstlane(tmask[1]);
            mn = strip4(((unsigned long long)hi << 32) | lo, wu & 3);
            const unsigned pk = mn ? tok4(mn) : 0u;
            tokn = (pk >> (8 * tsl)) & 0xffu;
            qn0 = *(const bf16x8*)(qbase + (size_t)tokn * 1024); qn1 = *(const bf16x8*)(qbase + (size_t)tokn * 1024 + 32);
        }
        auto iter = [&](const int j, u32x4& rk, u32x4& rv) __attribute__((always_inline)) {
            if (j + 1 <= cur) { bf16_t* Tn = Tl + ((j + 1) & 1) * NB_TILE; fp8_tile_st(Tn, rk); fp8_tile_st(Tn + 64 * KS, rv); }
            const unsigned long long mc = mn; const int tokc = tokn; const bf16x8 qc0 = qn0, qc1 = qn1;
            if (j + 1 <= cur) {
                const unsigned lo = __builtin_amdgcn_readfirstlane(tmask[(j + 1) * 2]), hi = __builtin_amdgcn_readfirstlane(tmask[(j + 1) * 2 + 1]);
                mn = strip4(((unsigned long long)hi << 32) | lo, (wu - (j + 1)) & 3);
                const unsigned pk = mn ? tok4(mn) : 0u;
                tokn = (pk >> (8 * tsl)) & 0xffu;
                if (mn) { qn0 = *(const bf16x8*)(qbase + (size_t)tokn * 1024); qn1 = *(const bf16x8*)(qbase + (size_t)tokn * 1024 + 32); }
            }
            if (j + 3 <= cur && dry_i != 3) { rk = *(const u32x4*)(Kg + (size_t)(j + 3) * 4096 + tid * 16); rv = *(const u32x4*)(Vg + (size_t)(j + 3) * 4096 + tid * 16); }
            if (mc != 0ull && dry_i != 2) {
                const bool diag = (j == cur);
                const bf16_t* Kq = Tl + (j & 1) * NB_TILE; const bf16_t* Vq = Kq + 64 * KS;
                int nrem = __builtin_popcountll(mc);
                nsa_b_cgroup(Kq, Vq, Mst, Lst, Ost, qc0, qc1, tokc, tsl < nrem, true, diag, r, lr, lg, ones);
                unsigned long long mg = mc;
                while (nrem > 16) {
                    mg = strip4(mg, 4); nrem -= 16;
                    const unsigned pk = tok4(mg);
                    const int tl = (pk >> (8 * tsl)) & 0xffu;
                    const bf16x8 a0 = *(const bf16x8*)(qbase + (size_t)tl * 1024), a1 = *(const bf16x8*)(qbase + (size_t)tl * 1024 + 32);
                    nsa_b_cgroup(Kq, Vq, Mst, Lst, Ost, a0, a1, tl, tsl < nrem, true, diag, r, lr, lg, ones);
                }
            }
            __syncthreads();
        };
        for (int j = 0; j <= cur; j += 2) {
            iter(j, rk1, rv1);
            if (j + 1 <= cur) iter(j + 1, rk0, rv0);
        }
#pragma unroll
        for (int c = 0; c < 4; ++c) {
            const int tloc = 16 * wid + 4 * c + tsl, col = tloc * 4 + r;
            const float lt = Lst[col];
            const size_t tok = (size_t)b * SEQ + t0 + tloc;
            const float sc = (lt > 0.f) ? p.gates0[tok * 48 + 16 + g * 4 + r] / lt : 0.f;
            bf16_t* op = p.o0 + tok * 1024 + (g * 4 + r) * 64;
            bf16_t* dp = dry ? (p.xn + tok * 1024 + (g * 4 + r) * 64) : op;
#pragma unroll
            for (int db = 0; db < 4; ++db) {
                const u32x2 ov = *(const u32x2*)(Ost + col * OST + 16 * db + 4 * lg);
                const u32x2 old = *(const u32x2*)(op + 16 * db + 4 * lg);
                u32x2 w;
                w.x = pack2(bflo(old.x) + bflo(ov.x) * sc, bfhi(old.x) + bfhi(ov.x) * sc);
                w.y = pack2(bflo(old.y) + bflo(ov.y) * sc, bfhi(old.y) + bfhi(ov.y) * sc);
                *(u32x2*)(dp + 16 * db + 4 * lg) = w;
            }
        }
    }
}

DI void ins16(unsigned (&t)[16], unsigned x) {
#pragma unroll
    for (int i = 0; i < 16; ++i) { const unsigned hi = max(t[i], x); x = min(t[i], x); t[i] = hi; }
}
DI void cex(unsigned& a, unsigned& b) { const unsigned hi = max(a, b), lo = min(a, b); a = hi; b = lo; }
DI void sort16_desc(unsigned (&v)[16]) {
#pragma unroll
    for (int k = 2; k <= 16; k <<= 1)
#pragma unroll
        for (int j = k >> 1; j >= 1; j >>= 1)
#pragma unroll
            for (int i = 0; i < 16; ++i) {
                const int l = i ^ j;
                if (l > i) { if ((i & k) == 0) cex(v[i], v[l]); else cex(v[l], v[i]); }
            }
}
DI void merge16_desc(unsigned (&t)[16], const unsigned (&c)[16]) {
#pragma unroll
    for (int i = 0; i < 16; ++i) t[i] = max(t[i], c[15 - i]);
#pragma unroll
    for (int j = 8; j >= 1; j >>= 1)
#pragma unroll
        for (int i = 0; i < 16; ++i) { const int l = i ^ j; if (l > i) cex(t[i], t[l]); }
}
DI void phase_topk(const Params& p, char* smem) {
    float* svals = (float*)smem;
    int* sidx = (int*)(svals + 256 * 17);
    const int tid = threadIdx.x;
    for (int blk = blockIdx.x; blk < NTOK / 16; blk += gridDim.x) {
        const int token = blk * 16 + (tid >> 4), list = tid & 15;
        const float* sp = p.scores + (size_t)token * 2048 + list * 128;
        unsigned tk[16];
#pragma unroll
        for (int i = 0; i < 16; ++i) tk[i] = 0u;
#pragma unroll 2
        for (int c = 0; c < 128; c += 16) {
            unsigned ck[16];
#pragma unroll
            for (int q = 0; q < 4; ++q) {
                const f32x4 v = *(const f32x4*)(sp + c + 4 * q);
#pragma unroll
                for (int e = 0; e < 4; ++e) ck[4 * q + e] = (ordf(v[e]) & 0xffffff80u) | (unsigned)(127 - (c + 4 * q + e));
            }
            sort16_desc(ck);
            merge16_desc(tk, ck);
        }
#pragma unroll
        for (int i = 0; i < 16; ++i) { svals[tid * 17 + i] = unordf(tk[i] & 0xffffff80u); sidx[tid * 17 + i] = 127 - (int)(tk[i] & 127u); }
        __syncthreads();
        if ((tid & 1) == 0) {
            unsigned t2[16];
#pragma unroll
            for (int i = 0; i < 16; ++i) t2[i] = 0u;
#pragma unroll
            for (int i = 0; i < 16; ++i) {
                const float a = svals[tid * 17 + i];
#pragma unroll
                for (int j = 0; j < 16; ++j)
                    if ((i + 1) * (j + 1) <= 16) ins16(t2, (ordf(a + svals[(tid + 1) * 17 + j]) & 0xffffff00u) | (unsigned)(255 - (i * 16 + j)));
            }
            const float smax = unordf(t2[0] & 0xffffff00u);
            float e[16], se = 0.f;
#pragma unroll
            for (int k = 0; k < 16; ++k) { e[k] = __expf(unordf(t2[k] & 0xffffff00u) - smax); se += e[k]; }
            const float inv = 1.0f / se;
            const size_t ob = ((size_t)token * 8 + (list >> 1)) * 16;
#pragma unroll
            for (int k = 0; k < 16; ++k) {
                const int pos = 255 - (int)(t2[k] & 255u), i = pos >> 4, j = pos & 15;
                p.eidx[ob + k] = sidx[tid * 17 + i] * 128 + sidx[(tid + 1) * 17 + j];
                p.egate[ob + k] = e[k] * inv;
            }
        }
        __syncthreads();
    }
}

DI void unpack16_fp8(const u32x4 r, float (&o)[16]) {
#pragma unroll
    for (int q = 0; q < 4; ++q) {
        const f32x2 lo = __builtin_amdgcn_cvt_pk_f32_fp8((int)r[q], false), hi = __builtin_amdgcn_cvt_pk_f32_fp8((int)r[q], true);
        o[4 * q] = lo.x; o[4 * q + 1] = lo.y; o[4 * q + 2] = hi.x; o[4 * q + 3] = hi.y;
    }
}
DI void reduce16(const float (&d)[16], int lane, float& c0, float& c1) {
    float a[8], b[4];
#pragma unroll
    for (int j = 0; j < 8; ++j) a[j] = swap32_add(d[j], d[j + 8]);
#pragma unroll
    for (int j = 0; j < 4; ++j) b[j] = swap16_add(a[j], a[j + 4]);
    const bool hi = lane & 8;
    const float k0 = hi ? b[2] : b[0], s0 = hi ? b[0] : b[2], k1 = hi ? b[3] : b[1], s1 = hi ? b[1] : b[3];
    c0 = octet_sum(k0 + dppf<0x128>(s0)); c1 = octet_sum(k1 + dppf<0x128>(s1));
}
DI float reduce8(const float (&d)[8], int lane) {
    float a[4], b[2];
#pragma unroll
    for (int j = 0; j < 4; ++j) a[j] = swap32_add(d[j], d[j + 4]);
#pragma unroll
    for (int j = 0; j < 2; ++j) b[j] = swap16_add(a[j], a[j + 2]);
    const bool hi = lane & 8;
    return octet_sum((hi ? b[1] : b[0]) + dppf<0x128>(hi ? b[0] : b[1]));
}
DI float dot16_fp8(const u32x4 r, const u32x4 x) {
    int acc = __builtin_amdgcn_sdot4((int)r.x, (int)x.x, 0, false);
    acc = __builtin_amdgcn_sdot4((int)r.y, (int)x.y, acc, false);
    acc = __builtin_amdgcn_sdot4((int)r.z, (int)x.z, acc, false);
    acc = __builtin_amdgcn_sdot4((int)r.w, (int)x.w, acc, false);
    return (float)acc;
}
DI void phase_peer_u(const Params& p, char* smem, const int dry_i) {
    const bool dry = dry_i != 0;
    const int lane = threadIdx.x & 63, wid = threadIdx.x >> 6;
    const int part0 = blockIdx.x & 7, rank = blockIdx.x >> 3, nrank = (gridDim.x - part0 + 7) >> 3;
    const int part = (dry_i == 4) ? (int)(xb_xcc_id() & 7u) : part0;
    int* Lbase = (int*)smem + wid * 768;
    float* cdst = dry ? p.scores : p.coef;
    const int j16 = ((lane >> 5) & 1) * 8 + ((lane >> 4) & 1) * 4 + ((lane >> 3) & 1) * 2 + (lane & 1);
    const int j8 = ((lane >> 5) & 1) * 4 + ((lane >> 4) & 1) * 2 + ((lane >> 3) & 1);
    const int tstride = nrank * 4;
    int t = rank * 4 + wid;
    int ev0 = 0, ev1 = 0; float gv0 = 0.f, gv1 = 0.f; u32x4 xraw = (u32x4){0u, 0u, 0u, 0u};
#define U_LOAD_RAW(tt) do { ev0 = p.eidx[(size_t)(tt) * 128 + lane]; ev1 = p.eidx[(size_t)(tt) * 128 + 64 + lane]; gv0 = p.egate[(size_t)(tt) * 128 + lane]; gv1 = p.egate[(size_t)(tt) * 128 + 64 + lane]; \
        xraw = *(const u32x4*)(p.xq8 + (size_t)(tt) * 1024 + 16 * lane); } while (0)
#define U_BUILD_LIST(buf, nout) do { int* L_idx_ = Lbase + (buf) * 384; float* L_gate_ = (float*)(L_idx_ + 128); int* L_pos_ = L_idx_ + 256; \
        const bool in0 = (ev0 >> 11) == part, in1 = (ev1 >> 11) == part; \
        const unsigned long long mk0 = __ballot(in0), mk1 = __ballot(in1); \
        const int n0_ = __popcll(mk0); nout = n0_ + __popcll(mk1); \
        asm volatile("" ::: "memory"); \
        if (in0) { const int r0 = __builtin_amdgcn_mbcnt_hi((unsigned)(mk0 >> 32), __builtin_amdgcn_mbcnt_lo((unsigned)mk0, 0u)); L_idx_[r0] = ev0; L_gate_[r0] = gv0; L_pos_[r0] = lane; } \
        if (in1) { const int r1 = n0_ + __builtin_amdgcn_mbcnt_hi((unsigned)(mk1 >> 32), __builtin_amdgcn_mbcnt_lo((unsigned)mk1, 0u)); L_idx_[r1] = ev1; L_gate_[r1] = gv1; L_pos_[r1] = 64 + lane; } \
        asm volatile("s_waitcnt lgkmcnt(0)" ::: "memory"); } while (0)
    int nC = 0, cb = 0; u32x4 xC = xraw; u32x4 rrC[16];
#pragma unroll
    for (int j = 0; j < 16; ++j) rrC[j] = (u32x4){0u, 0u, 0u, 0u};
    if (t < NTOK) {
        U_LOAD_RAW(t);
        U_BUILD_LIST(0, nC); xC = xraw;
        const int* L_idx = Lbase;
#pragma unroll
        for (int j = 0; j < 16; ++j) rrC[j] = *(const u32x4*)(p.u8 + (size_t)(L_idx[j < nC ? j : 0] & 16383) * 1024 + 16 * lane);
        if (t + tstride < NTOK) U_LOAD_RAW(t + tstride);
    }
    for (; t < NTOK; t += tstride) {
        const int tn = t + tstride;
        int nN = 0; u32x4 xN = xraw; u32x4 rrN[16];
        if (tn < NTOK) {
            U_BUILD_LIST(cb ^ 1, nN); xN = xraw;
            const int* Ln = Lbase + (cb ^ 1) * 384;
#pragma unroll
            for (int j = 0; j < 16; ++j) rrN[j] = *(const u32x4*)(p.u8 + (size_t)(Ln[j < nN ? j : 0] & 16383) * 1024 + 16 * lane);
            if (tn + tstride < NTOK) U_LOAD_RAW(tn + tstride);
        } else {
#pragma unroll
            for (int j = 0; j < 16; ++j) rrN[j] = (u32x4){0u, 0u, 0u, 0u};
        }
        const int* L_idx = Lbase + cb * 384; const float* L_gate = (const float*)(L_idx + 128); const int* L_pos = L_idx + 256;
        const int n = nC;
        u32x4 r2[8];
        const bool more = n > 16;
        if (more) {
#pragma unroll
            for (int j = 0; j < 8; ++j) { const int sl = 16 + j; r2[j] = *(const u32x4*)(p.u8 + (size_t)(L_idx[sl < n ? sl : 0] & 16383) * 1024 + 16 * lane); }
        }
        if (n > 0) {
            float d[16];
#pragma unroll
            for (int j = 0; j < 16; ++j) d[j] = dot16_fp8(rrC[j], xC);
            float c0, c1; reduce16(d, lane, c0, c1);
            { const int sl = j16; if ((lane & 7) < 2 && sl < n) cdst[(size_t)t * 128 + L_pos[sl]] = gelu_tanh(((lane & 1) ? c1 : c0) * (1.0f / (U8_SCALE * X8_SCALE))) * L_gate[sl] * FP8_INV; }
        }
        if (more) {
            float d2[8];
#pragma unroll
            for (int j = 0; j < 8; ++j) d2[j] = dot16_fp8(r2[j], xC);
            const float tot2 = reduce8(d2, lane);
            const int sl = 16 + j8; if ((lane & 7) == 0 && sl < n) cdst[(size_t)t * 128 + L_pos[sl]] = gelu_tanh(tot2 * (1.0f / (U8_SCALE * X8_SCALE))) * L_gate[sl] * FP8_INV;
        }
        for (int base = 24; base < n; base += 8) {
            float d2[8];
#pragma unroll
            for (int j = 0; j < 8; ++j) { const int sl = base + j; d2[j] = dot16_fp8(*(const u32x4*)(p.u8 + (size_t)L_idx[sl < n ? sl : 0] * 1024 + 16 * lane), xC); }
            const float tot2 = reduce8(d2, lane);
            const int sl = base + j8; if ((lane & 7) == 0 && sl < n) cdst[(size_t)t * 128 + L_pos[sl]] = gelu_tanh(tot2 * (1.0f / (U8_SCALE * X8_SCALE))) * L_gate[sl] * FP8_INV;
        }
        asm volatile("" ::: "memory");
        nC = nN; xC = xN; cb ^= 1;
#pragma unroll
        for (int j = 0; j < 16; ++j) rrC[j] = rrN[j];
    }
}
DI void phase_peer_v(const Params& p, const bool dry) {
    const int lane = threadIdx.x & 63, wid = threadIdx.x >> 6, pg = lane >> 3, li = lane & 7;
    const int sl = blockIdx.x & 7, rank = blockIdx.x >> 3, nrank = (gridDim.x - sl + 7) >> 3;
    const unsigned char* vt = p.v8s + (size_t)sl * 16384 * 128 + 16 * li;
    int t = rank * 4 + wid;
    int e0 = 0, e1 = 0; float c0 = 0.f, c1 = 0.f;
    if (t < NTOK) { e0 = p.eidx[(size_t)t * 128 + lane]; e1 = p.eidx[(size_t)t * 128 + 64 + lane]; c0 = p.coef[(size_t)t * 128 + lane]; c1 = p.coef[(size_t)t * 128 + 64 + lane]; }
    for (; t < NTOK; t += nrank * 4) {
        const int tn = t + nrank * 4;
        const size_t o = (size_t)t * 1024 + 128 * sl + 16 * li + 2 * pg;
        f32x2 acc[8];
#pragma unroll
        for (int j = 0; j < 8; ++j) acc[j] = (f32x2){0.f, 0.f};
        u32x4 r[16]; float c[16];
#pragma unroll
        for (int k = 0; k < 16; ++k) {
            const int src = (8 * k + pg) & 63;
            const int e = __shfl(k < 8 ? e0 : e1, src);
            c[k] = __shfl(k < 8 ? c0 : c1, src);
            r[k] = *(const u32x4*)(vt + (size_t)e * 128);
        }
        __builtin_amdgcn_sched_barrier(0);
        f32x2 cur = *(const f32x2*)(p.out + o);
        int ne0 = 0, ne1 = 0; float nc0 = 0.f, nc1 = 0.f;
        if (tn < NTOK) { ne0 = p.eidx[(size_t)tn * 128 + lane]; ne1 = p.eidx[(size_t)tn * 128 + 64 + lane]; nc0 = p.coef[(size_t)tn * 128 + lane]; nc1 = p.coef[(size_t)tn * 128 + 64 + lane]; }
        __builtin_amdgcn_sched_barrier(0);
#pragma unroll
        for (int k = 0; k < 16; ++k) {
            const f32x2 ck = {c[k], c[k]};
#pragma unroll
            for (int q = 0; q < 4; ++q) {
                acc[2 * q] += ck * __builtin_amdgcn_cvt_pk_f32_fp8((int)r[k][q], false);
                acc[2 * q + 1] += ck * __builtin_amdgcn_cvt_pk_f32_fp8((int)r[k][q], true);
            }
        }
        float a8[8], a4[4], a2[2];
#pragma unroll
        for (int j = 0; j < 4; ++j) { a8[2 * j] = swap32_add(acc[j].x, acc[j + 4].x); a8[2 * j + 1] = swap32_add(acc[j].y, acc[j + 4].y); }
#pragma unroll
        for (int j = 0; j < 4; ++j) a4[j] = swap16_add(a8[j], a8[j + 4]);
        {
            const bool hi = pg & 1;
            a2[0] = (hi ? a4[2] : a4[0]) + dppf<0x128>(hi ? a4[0] : a4[2]);
            a2[1] = (hi ? a4[3] : a4[1]) + dppf<0x128>(hi ? a4[1] : a4[3]);
        }
        cur.x += a2[0]; cur.y += a2[1];
        *(f32x2*)((dry ? p.scores : p.out) + o) = cur;
        e0 = ne0; e1 = ne1; c0 = nc0; c1 = nc1;
    }
}

DI void phase_cumsum(const Params& p, char* smem) {
    float* part = (float*)smem;
    const int tid = threadIdx.x;
    for (int u = blockIdx.x; u < 512; u += gridDim.x) {
        const int bh = u >> 4, ch = u & 15, b = bh >> 4, h = bh & 15, sub = tid & 7;
        float kmax = 0.f, qmax = 0.f;
        for (int it = 0; it < 32; ++it) {
            const int s = ch * 1024 + it * 32 + (tid >> 3);
            const u32x4 kv = *(const u32x4*)(p.k1 + ((size_t)bh * SEQ + s) * 64 + sub * 8);
            const u32x4 qv = *(const u32x4*)(p.q1 + ((size_t)b * SEQ + s) * 1024 + h * 64 + sub * 8);
            float ks = 0.f, qs = 0.f;
#pragma unroll
            for (int i = 0; i < 4; ++i) { ks += bflo(kv[i]) * bflo(kv[i]) + bfhi(kv[i]) * bfhi(kv[i]); qs += bflo(qv[i]) * bflo(qv[i]) + bfhi(qv[i]) * bfhi(qv[i]); }
            ks += __shfl_xor(ks, 1); ks += __shfl_xor(ks, 2); ks += __shfl_xor(ks, 4);
            qs += __shfl_xor(qs, 1); qs += __shfl_xor(qs, 2); qs += __shfl_xor(qs, 4);
            kmax = fmaxf(kmax, ks); qmax = fmaxf(qmax, qs);
        }
#pragma unroll
        for (int off = 8; off <= 32; off <<= 1) { kmax = fmaxf(kmax, __shfl_xor(kmax, off)); qmax = fmaxf(qmax, __shfl_xor(qmax, off)); }
        if ((tid & 63) == 0) { atomicMax(&p.nrm[bh * 2], __float_as_uint(kmax * 1.02f)); atomicMax(&p.nrm[bh * 2 + 1], __float_as_uint(qmax * 1.02f)); }
    }
    for (int seq = blockIdx.x; seq < 32; seq += gridDim.x) {
        float* c = p.cfox + (size_t)seq * SEQ + tid * 64;
        float s = 0.f;
        for (int i = 0; i < 64; i += 4) { const f32x4 v = *(const f32x4*)(c + i); s += (v[0] + v[1]) + (v[2] + v[3]); }
        __syncthreads();
        part[tid] = s;
        __syncthreads();
        float run = 0.f;
        for (int i = 0; i < tid; ++i) run += part[i];
        for (int i = 0; i < 64; i += 4) {
            f32x4 v = *(const f32x4*)(c + i);
            v[0] += run; v[1] += v[0]; v[2] += v[1]; v[3] += v[2]; run = v[3];
            *(f32x4*)(c + i) = v;
        }
    }
}

constexpr int N_PHASES = 23;
#ifndef PROBE_PHASE
#define PROBE_PHASE -1
#endif
#ifndef PROBE_DRY
#define PROBE_DRY 1
#endif
constexpr int cmax(int a, int b) { return a > b ? a : b; }
constexpr int LDS_BYTES = 16 + 64 + cmax(cmax(NSB_LDS, 384 * GS * 2), 2 * 64 * KS * 2 + 32 * IST * 4);
static_assert(LDS_BYTES >= 16 + 256 * 17 * 8, "topk tables must fit");

__global__ void __launch_bounds__(256, 2) mega(Params p, int ph_lo, int ph_hi, int dry_i) {
    const bool dry = dry_i != 0;
    extern __shared__ __attribute__((aligned(16))) char smem_all[];
    char* smem = smem_all + 16;
    const bool multi = (ph_hi - ph_lo) > 1;
    XcdBarrier bar;
    if (multi) {
        if (threadIdx.x == 0) *(uint4*)smem_all = make_uint4(0u, 0u, 0u, 0u);
        __syncthreads();
        bar = xcd_barrier_post(p.bar, (volatile LAS unsigned*)smem_all);
    }
#define PHASE(i, ...) if (ph_lo <= (i) && (i) < ph_hi) { __VA_ARGS__; if ((i) + 1 < ph_hi) xcd_barrier(bar); }
    PHASE(0, phase_prologue(p))
    PHASE(1, phase_gemm_in0(p, smem))
    PHASE(2, phase_cmp1(p, smem))
    PHASE(3, phase_cmp2(p, smem))
    PHASE(4, phase_nsa_a(p, smem))
    PHASE(5, phase_nsa_b(p, smem, dry_i))
    PHASE(6, phase_gemm_out(p.o0, p.wt_out0, p.x, p.out, smem))
    PHASE(7, rmsnorm_pipe<1>(p.out, p.l0_ffn_norm, p.xn, nullptr, p.xq8))
    PHASE(8, phase_gemm_scores(p, p.weff0, smem))
    PHASE(9, phase_topk(p, smem))
    PHASE(10, phase_peer_u(p, smem, dry_i))
    PHASE(11, phase_peer_v(p, dry))
    PHASE(12, { rmsnorm_pipe<0>(p.out, p.l1_attn_norm, p.xn, nullptr, nullptr);
                const int gtid = blockIdx.x * blockDim.x + threadIdx.x, gsz = gridDim.x * blockDim.x;
                convert_tables_fp8(p.l1_u, p.l1_v, p.u8, p.v8s, gtid, gsz); if (gtid < 64) p.nrm[gtid] = 0u; })
    PHASE(13, phase_gemm_in1(p, smem))
    PHASE(14, phase_cumsum(p, smem))
    PHASE(15, phase_fox(p, smem))
    PHASE(16, phase_gemm_out(p.o1, p.wt_out1, p.out, p.out, smem))
    PHASE(17, rmsnorm_pipe<1>(p.out, p.l1_ffn_norm, p.xn, nullptr, p.xq8))
    PHASE(18, phase_gemm_scores(p, p.weff1, smem))
    PHASE(19, phase_topk(p, smem))
    PHASE(20, phase_peer_u(p, smem, dry_i))
    PHASE(21, phase_peer_v(p, dry))
    PHASE(22, rmsnorm_pipe<2>(p.out, p.final_norm, nullptr, p.out, nullptr))
#undef PHASE
}

#ifndef MK_ONE_LAUNCH
#define MK_ONE_LAUNCH 1
#endif
extern "C" void kernel_launch(void* const* d_in, const int* in_sizes, int n_in, void* d_out, int out_size, void* d_ws, size_t ws_size, hipStream_t stream) {
    (void)in_sizes; (void)n_in; (void)out_size;
    Params p{};
    const float* const* in = (const float* const*)d_in;
    p.x = in[0]; p.l0_attn_norm = in[1]; p.l0_w_in = in[2]; p.l0_pe_k = in[3]; p.l0_w1_k = in[4]; p.l0_w2_k = in[5]; p.l0_pe_v = in[6]; p.l0_w1_v = in[7]; p.l0_w2_v = in[8];
    p.l0_w_out = in[9]; p.l0_ffn_norm = in[10]; p.l0_wq = in[11]; p.l0_keys = in[12]; p.l0_u = in[13]; p.l0_v = in[14];
    p.l1_attn_norm = in[15]; p.l1_w_in = in[16]; p.l1_f_bias = in[17]; p.l1_w_out = in[18]; p.l1_ffn_norm = in[19]; p.l1_wq = in[20]; p.l1_keys = in[21]; p.l1_u = in[22]; p.l1_v = in[23];
    p.final_norm = in[24];
    p.out = (float*)d_out;
    char* w = (char*)d_ws; size_t off = 0;
    auto take = [&](size_t bytes) { char* r = w + off; off += (bytes + 255) & ~(size_t)255; return r; };
    p.bar = (unsigned*)take(XCD_BAR_WORDS * 4);
    p.rope = (float2*)take((size_t)SEQ * 32 * 8);
    p.wt_in0 = (bf16_t*)take((size_t)NSA_NP * 1024 * 2); p.wt_out0 = (bf16_t*)take((size_t)1024 * 1024 * 2);
    p.wq0b = (bf16_t*)take((size_t)1024 * 2048 * 2); p.keys0b = (bf16_t*)take((size_t)16 * 128 * 128 * 2); p.weff0 = (bf16_t*)take((size_t)2048 * 1024 * 2);
    p.wt_in1 = (bf16_t*)take((size_t)FOX_NP * 1024 * 2); p.wt_out1 = (bf16_t*)take((size_t)1024 * 1024 * 2);
    p.wq1b = (bf16_t*)take((size_t)1024 * 2048 * 2); p.keys1b = (bf16_t*)take((size_t)16 * 128 * 128 * 2); p.weff1 = (bf16_t*)take((size_t)2048 * 1024 * 2);
    p.w1t = (bf16_t*)take((size_t)8 * 128 * 2048 * 2); p.w2t = (bf16_t*)take((size_t)8 * 128 * 128 * 2); p.b1 = (float*)take(16 * 1024 * 4);
    p.u8 = (unsigned char*)take((size_t)16384 * 1024); p.v8s = (unsigned char*)take((size_t)16384 * 1024); p.coef = (float*)take((size_t)NTOK * 128 * 4);
    p.xn = (bf16_t*)take((size_t)NTOK * 1024 * 2); p.xq8 = (unsigned char*)take((size_t)NTOK * 1024);
    p.eidx = (int*)take((size_t)NTOK * 128 * 4); p.egate = (float*)take((size_t)NTOK * 128 * 4);
    p.cfox = (float*)take((size_t)32 * SEQ * 4); p.nrm = (unsigned*)take(256);
    char* act = take((size_t)256 << 20);
    {
        size_t a = 0; auto tk = [&](size_t bytes) { char* r = act + a; a += (bytes + 255) & ~(size_t)255; return r; };
        p.q0 = (bf16_t*)tk((size_t)NTOK * 1024 * 2);
        p.kcin = (bf16_t*)tk((size_t)8 * SEQ * 64 * 2); p.vcin = (bf16_t*)tk((size_t)8 * SEQ * 64 * 2); p.kslc = (bf16_t*)tk((size_t)8 * SEQ * 64 * 2);
        p.vslcT = (bf16_t*)tk((size_t)8 * SEQ * 64 * 2); p.kwin = (bf16_t*)tk((size_t)8 * SEQ * 64 * 2); p.vwinT = (bf16_t*)tk((size_t)8 * SEQ * 64 * 2);
        p.o0 = (bf16_t*)tk((size_t)NTOK * 1024 * 2);
        p.gates0 = (float*)tk((size_t)NTOK * 48 * 4); p.sel = (int*)tk((size_t)NTOK * 64 * 4);
        p.kcmp = (bf16_t*)tk((size_t)8 * 1024 * 64 * 2); p.vcmpT = (bf16_t*)tk((size_t)8 * 1024 * 64 * 2); p.hid = (bf16_t*)tk((size_t)16 * 1024 * 128 * 2);
        if (a > ((size_t)256 << 20)) { fprintf(stderr, "activation overlay too large\n"); return; }
        p.scores = (float*)act;
        p.q1 = (bf16_t*)act; p.k1 = p.q1 + (size_t)NTOK * 1024; p.v1T = p.k1 + (size_t)NTOK * 1024; p.o1 = p.v1T + (size_t)NTOK * 1024;
    }
    if (off > ws_size) { fprintf(stderr, "workspace too small: need %zu have %zu\n", off, ws_size); return; }

    static int grid = 0;
    if (!grid) {
        int dev = 0, cus = 0, per_cu = 0;
        hipGetDevice(&dev);
        hipDeviceGetAttribute(&cus, hipDeviceAttributeMultiprocessorCount, dev);
        if (hipFuncSetAttribute((const void*)mega, hipFuncAttributeMaxDynamicSharedMemorySize, LDS_BYTES) != hipSuccess) fprintf(stderr, "kernel_launch: hipFuncSetAttribute(%d B LDS) failed\n", LDS_BYTES);
        hipOccupancyMaxActiveBlocksPerMultiprocessor(&per_cu, mega, 256, LDS_BYTES);
        if (per_cu > 2) per_cu = 2;
        if (per_cu < 1) per_cu = 1;
        grid = cus * per_cu;
    }
#if PROBE_PHASE >= 0
    for (int i = 0; i < N_PHASES; ++i) {
        if (i == PROBE_PHASE) hipLaunchKernelGGL(mega, dim3(grid), dim3(256), LDS_BYTES, stream, p, i, i + 1, PROBE_DRY);
        hipLaunchKernelGGL(mega, dim3(grid), dim3(256), LDS_BYTES, stream, p, i, i + 1, 0);
    }
#elif MK_ONE_LAUNCH
    hipMemsetAsync(p.bar, 0, XCD_BAR_WORDS * 4, stream);
    hipLaunchKernelGGL(mega, dim3(grid), dim3(256), LDS_BYTES, stream, p, 0, N_PHASES, 0);
#else
    for (int i = 0; i < N_PHASES; ++i) hipLaunchKernelGGL(mega, dim3(grid), dim3(256), LDS_BYTES, stream, p, i, i + 1, 0);
#endif
}
```

```cpp
#include <hip/hip_runtime.h>
#include <stdint.h>
#include <stdio.h>

#define DI __device__ __forceinline__
typedef unsigned short bf16_t;
typedef short bf16x8 __attribute__((ext_vector_type(8)));
typedef short s16x4 __attribute__((ext_vector_type(4)));
typedef float f32x4 __attribute__((ext_vector_type(4)));
typedef float f32x16 __attribute__((ext_vector_type(16)));
typedef unsigned u32x4 __attribute__((ext_vector_type(4)));
typedef unsigned u32x2 __attribute__((ext_vector_type(2)));

constexpr int DM = 1024, BATCH = 2, SEQ = 16384, NTOK = BATCH * SEQ;
constexpr int NSA_N = 2608, NSA_NP = 2816, FOX_N = 3088, FOX_NP = 3328;
constexpr float LOG2E = 1.4426950408889634f;
#define NEGINF (-__builtin_inff())

#define XB_TMO      128
#define XB_XCNT(j)  (256  + 64 * (j))
#define XB_XSUB(j)  (1280 + 64 * (j))
#define XB_XGEN(j)  (2304 + 64 * (j))
#define XB_TOP      3328
#define XB_TOPGEN   3392
#define XCD_BAR_WORDS 3456
#define XB_SPIN_CAP (1u << 18)
#define LAS __attribute__((address_space(3)))

__device__ __forceinline__ unsigned xb_ld(unsigned* p)              { return __hip_atomic_load(p, __ATOMIC_RELAXED, __HIP_MEMORY_SCOPE_AGENT); }
__device__ __forceinline__ unsigned xb_add(unsigned* p, unsigned v) { return __hip_atomic_fetch_add(p, v, __ATOMIC_RELAXED, __HIP_MEMORY_SCOPE_AGENT); }
__device__ __forceinline__ unsigned xb_xcc_id() { return (unsigned)__builtin_amdgcn_s_getreg((3 << 11) | 20) & 0xFu; }
#define XB_SPIN(cond, bar) do { unsigned _sp = 0; while (cond) { __builtin_amdgcn_s_sleep(1); \
    if ((++_sp & 255u) == 0u) { if (xb_ld(&(bar)[XB_TMO])) break; if (_sp > XB_SPIN_CAP) { atomicAdd(&(bar)[XB_TMO], 1u); break; } } } } while (0)

struct XcdBarrier { unsigned* bar; unsigned x; volatile LAS unsigned* st; };

__device__ __forceinline__ XcdBarrier xcd_barrier_post(unsigned* bar, volatile LAS unsigned* st) {
    XcdBarrier b; b.bar = bar; b.x = xb_xcc_id(); b.st = st;
    if (threadIdx.x == 0) (void)xb_add(&bar[XB_XCNT(b.x)], 1u);
    return b;
}
__device__ __forceinline__ void xcd_barrier_complete(unsigned* bar, unsigned x, unsigned& nloc, unsigned& nx) {
    const unsigned G = gridDim.x * gridDim.y * gridDim.z;
    unsigned sum, cnt, mine, sp = 0u;
    for (;;) {
        sum = 0u; cnt = 0u; mine = 0u;
#pragma unroll
        for (unsigned j = 0; j < 16; ++j) { const unsigned c = xb_ld(&bar[XB_XCNT(j)]); sum += c; cnt += (c > 0u) ? 1u : 0u; mine = (j == x) ? c : mine; }
        if (sum == G) break;
        __builtin_amdgcn_s_sleep(1);
        if ((++sp & 255u) == 0u) { if (xb_ld(&bar[XB_TMO])) break; if (sp > XB_SPIN_CAP) { atomicAdd(&bar[XB_TMO], 1u); break; } }
    }
    nloc = mine > 0u ? mine : 1u; nx = cnt > 0u ? cnt : 1u;
}
__device__ __forceinline__ void xcd_barrier(const XcdBarrier& b) {
    asm volatile("s_waitcnt vmcnt(0)" ::: "memory");
    __syncthreads();
    if (threadIdx.x == 0) {
        unsigned* bar = b.bar;
        __builtin_amdgcn_s_waitcnt(0);
        unsigned nloc = b.st[0], nx = b.st[1];
        if (nloc == 0u) { xcd_barrier_complete(bar, b.x, nloc, nx); b.st[0] = nloc; b.st[1] = nx; }
        const unsigned old = xb_add(&bar[XB_XSUB(b.x)], 1u);
        const unsigned gen = old / nloc;
        if (old + 1u == (gen + 1u) * nloc) {
            __builtin_amdgcn_fence(__ATOMIC_RELEASE, "agent");
            asm volatile("s_waitcnt vmcnt(0)" ::: "memory");
            const unsigned og = xb_add(&bar[XB_TOP], 1u);
            const unsigned tg = og / nx;
            if (og + 1u == (tg + 1u) * nx) xb_add(&bar[XB_TOPGEN], 1u);
            else XB_SPIN(xb_ld(&bar[XB_TOPGEN]) == tg, bar);
            __builtin_amdgcn_fence(__ATOMIC_ACQUIRE, "agent");
            xb_add(&bar[XB_XGEN(b.x)], 1u);
            asm volatile("s_waitcnt vmcnt(0)" ::: "memory");
        } else {
            XB_SPIN(xb_ld(&bar[XB_XGEN(b.x)]) == gen, bar);
            __builtin_amdgcn_fence(__ATOMIC_ACQUIRE, "agent");
            asm volatile("s_waitcnt vmcnt(0)" ::: "memory");
        }
    }
    __syncthreads();
}

struct Params {
    const float *x, *l0_attn_norm, *l0_w_in, *l0_pe_k, *l0_w1_k, *l0_w2_k, *l0_pe_v, *l0_w1_v, *l0_w2_v, *l0_w_out, *l0_ffn_norm, *l0_wq, *l0_keys, *l0_u, *l0_v;
    const float *l1_attn_norm, *l1_w_in, *l1_f_bias, *l1_w_out, *l1_ffn_norm, *l1_wq, *l1_keys, *l1_u, *l1_v, *final_norm;
    float* out;
    unsigned* bar; float2* rope;
    bf16_t *wt_in0, *wt_out0, *wq0b, *keys0b, *weff0, *wt_in1, *wt_out1, *wq1b, *keys1b, *weff1, *w1t, *w2t;
    float* b1;
    unsigned char *u8, *v8s; float* coef;
    bf16_t* xn; unsigned char* xq8;
    bf16_t *q0, *kcin, *vcin, *kslc, *vslcT, *kwin, *vwinT, *o0, *kcmp, *vcmpT, *hid;
    float* gates0; int* sel;
    float* scores; int* eidx; float* egate;
    bf16_t *q1, *k1, *v1T, *o1;
    float* cfox; unsigned* nrm;
};

DI float bf2f(bf16_t v) { return __uint_as_float((unsigned)v << 16); }
DI bf16_t f2bf(float f) { __bf16 b = (__bf16)f; return __builtin_bit_cast(bf16_t, b); }
typedef __bf16 bf16x2_t __attribute__((ext_vector_type(2)));
typedef float f32x2 __attribute__((ext_vector_type(2)));
DI unsigned pack2(float lo, float hi) { const f32x2 v = {lo, hi}; return __builtin_bit_cast(unsigned, __builtin_convertvector(v, bf16x2_t)); }
DI float bflo(unsigned w) { return __uint_as_float(w << 16); }
DI float bfhi(unsigned w) { return __uint_as_float(w & 0xffff0000u); }
DI float gelu_tanh(float x) {
    const float y = 0.7978845608028654f * (x + 0.044715f * x * x * x);
    const float e = __expf(2.0f * y);
    const float t = 1.0f - 2.0f / (e + 1.0f);
    return 0.5f * x * (1.0f + t);
}
DI unsigned ordf(float f) { const unsigned u = __float_as_uint(f); return u ^ ((u & 0x80000000u) ? 0xffffffffu : 0x80000000u); }
DI float unordf(unsigned o) { const unsigned u = o ^ ((o & 0x80000000u) ? 0x80000000u : 0xffffffffu); return __uint_as_float(u); }
#define MFMA16(a, b, c) __builtin_amdgcn_mfma_f32_16x16x32_bf16((a), (b), (c), 0, 0, 0)
#define MFMA32(a, b, c) __builtin_amdgcn_mfma_f32_32x32x16_bf16((a), (b), (c), 0, 0, 0)

DI float xhalf_max(float x) { const auto t = __builtin_amdgcn_permlane32_swap(__float_as_uint(x), __float_as_uint(x), false, false); return fmaxf(__uint_as_float(t[0]), __uint_as_float(t[1])); }
DI float xhalf_sum(float x) { const auto t = __builtin_amdgcn_permlane32_swap(__float_as_uint(x), __float_as_uint(x), false, false); return __uint_as_float(t[0]) + __uint_as_float(t[1]); }
DI float swap32_add(float x, float y) { const auto t = __builtin_amdgcn_permlane32_swap(__float_as_uint(x), __float_as_uint(y), false, false); return __uint_as_float(t[0]) + __uint_as_float(t[1]); }
DI float swap16_add(float x, float y) { const auto t = __builtin_amdgcn_permlane16_swap(__float_as_uint(x), __float_as_uint(y), false, false); return __uint_as_float(t[0]) + __uint_as_float(t[1]); }
DI float dpp_f(float x, int ctrl_unused) { return x; }
template <int CTRL> DI float dppf(float x) { return __builtin_bit_cast(float, __builtin_amdgcn_update_dpp(0, __builtin_bit_cast(int, x), CTRL, 0xF, 0xF, true)); }
DI float octet_sum(float x) { x += dppf<0xB1>(x); x += dppf<0x4E>(x); x += dppf<0x141>(x); return x; }
DI float xrow16_sum(float x) { const auto s_ = __builtin_amdgcn_permlane16_swap(__float_as_uint(x), __float_as_uint(x), false, false); return xhalf_sum(__uint_as_float(s_[0]) + __uint_as_float(s_[1])); }
DI float xrow16_max(float x) { const auto s = __builtin_amdgcn_permlane16_swap(__float_as_uint(x), __float_as_uint(x), false, false); return xhalf_max(fmaxf(__uint_as_float(s[0]), __uint_as_float(s[1]))); }
constexpr float FP8_SCALE = 256.0f, FP8_INV = 1.0f / 256.0f;
DI unsigned pack4_fp8(float a, float b, float c, float d) {
    int w = 0;
    w = __builtin_amdgcn_cvt_pk_fp8_f32(a, b, w, false);
    w = __builtin_amdgcn_cvt_pk_fp8_f32(c, d, w, true);
    return (unsigned)w;
}
DI void cex(unsigned& a, unsigned& b) { const unsigned hi = max(a, b), lo = min(a, b); a = hi; b = lo; }
DI void sort16_desc(unsigned (&v)[16]) {
#pragma unroll
    for (int k = 2; k <= 16; k <<= 1)
#pragma unroll
        for (int j = k >> 1; j >= 1; j >>= 1)
#pragma unroll
            for (int i = 0; i < 16; ++i) {
                const int l = i ^ j;
                if (l > i) { if ((i & k) == 0) cex(v[i], v[l]); else cex(v[l], v[i]); }
            }
}
DI void merge16_desc(unsigned (&t)[16], const unsigned (&c)[16]) {
#pragma unroll
    for (int i = 0; i < 16; ++i) t[i] = max(t[i], c[15 - i]);
#pragma unroll
    for (int j = 8; j >= 1; j >>= 1)
#pragma unroll
        for (int i = 0; i < 16; ++i) { const int l = i ^ j; if (l > i) cex(t[i], t[l]); }
}
typedef int i32x4 __attribute__((ext_vector_type(4)));
template <class T, class = void> struct epi_stages { static constexpr bool value = false; };
template <class T> struct epi_stages<T, decltype((void)T::STAGE)> { static constexpr bool value = T::STAGE; };
template <class T, class = void> struct epi_whole { static constexpr bool value = false; };
template <class T> struct epi_whole<T, decltype((void)T::WHOLE)> { static constexpr bool value = T::WHOLE; };
constexpr int GS = 72;
template <class Epi>
DI void gemm_tile(const bf16_t* __restrict__ A, int lda, const bf16_t* __restrict__ B, int ldb, int K, int m0, int n0, const Epi& epi, bf16_t* As, bf16_t* Bs) {
    const int tid = threadIdx.x, lane = tid & 63, wid = tid >> 6, wm = wid >> 1, wn = wid & 1, lr = lane & 15, lg = lane >> 4;
    f32x4 acc[4][4];
#pragma unroll
    for (int i = 0; i < 4; ++i)
#pragma unroll
        for (int j = 0; j < 4; ++j) acc[i][j] = (f32x4){0.f, 0.f, 0.f, 0.f};
    const int crow = tid >> 3, ckc = tid & 7;
    const bf16_t* ap = A + (size_t)(m0 + crow) * lda + ckc * 8;
    const bf16_t* bp = B + (size_t)(n0 + crow) * ldb + ckc * 8;
    u32x4 ra[4], rb[4];
#pragma unroll
    for (int i = 0; i < 4; ++i) { ra[i] = *(const u32x4*)(ap + (size_t)(32 * i) * lda); rb[i] = *(const u32x4*)(bp + (size_t)(32 * i) * ldb); }
    const int nk = K >> 6;
    for (int kt = 0; kt < nk; ++kt) {
        __syncthreads();
#pragma unroll
        for (int i = 0; i < 4; ++i) { *(u32x4*)(As + (crow + 32 * i) * GS + ckc * 8) = ra[i]; *(u32x4*)(Bs + (crow + 32 * i) * GS + ckc * 8) = rb[i]; }
        __syncthreads();
        if (kt + 1 < nk) {
            ap += 64; bp += 64;
#pragma unroll
            for (int i = 0; i < 4; ++i) { ra[i] = *(const u32x4*)(ap + (size_t)(32 * i) * lda); rb[i] = *(const u32x4*)(bp + (size_t)(32 * i) * ldb); }
        }
#pragma unroll
        for (int ks = 0; ks < 2; ++ks) {
            bf16x8 a[4], b[4];
#pragma unroll
            for (int i = 0; i < 4; ++i) {
                a[i] = *(const bf16x8*)(As + (wm * 64 + i * 16 + lr) * GS + ks * 32 + lg * 8);
                b[i] = *(const bf16x8*)(Bs + (wn * 64 + i * 16 + lr) * GS + ks * 32 + lg * 8);
            }
#pragma unroll
            for (int i = 0; i < 4; ++i)
#pragma unroll
                for (int j = 0; j < 4; ++j) acc[i][j] = MFMA16(a[i], b[j], acc[i][j]);
        }
    }
    epi(acc, m0 + wm * 64, n0 + wn * 64, lr, lg);
}

template <class Epi>
DI void gemm_tile_w(const bf16_t* __restrict__ A, int lda, const bf16_t* __restrict__ B, int ldb, int K, int m0, int n0, const Epi& epi, bf16_t* As, bf16_t* Bs) {
    const int tid = threadIdx.x, lane = tid & 63, wid = tid >> 6, wm = wid >> 1, wn = wid & 1, lr = lane & 15, lg = lane >> 4;
    f32x4 acc[2][4][4];
#pragma unroll
    for (int h = 0; h < 2; ++h)
#pragma unroll
        for (int i = 0; i < 4; ++i)
#pragma unroll
            for (int j = 0; j < 4; ++j) acc[h][i][j] = (f32x4){0.f, 0.f, 0.f, 0.f};
    const int crow = tid >> 3, ckc = tid & 7;
    const bf16_t* ap = A + (size_t)(m0 + crow) * lda + ckc * 8;
    const bf16_t* bp = B + (size_t)(n0 + crow) * ldb + ckc * 8;
    u32x4 ra[4], rb[8];
#pragma unroll
    for (int i = 0; i < 4; ++i) ra[i] = *(const u32x4*)(ap + (size_t)(32 * i) * lda);
#pragma unroll
    for (int i = 0; i < 8; ++i) rb[i] = *(const u32x4*)(bp + (size_t)(32 * i) * ldb);
    const int nk = K >> 6;
    for (int kt = 0; kt < nk; ++kt) {
        __syncthreads();
#pragma unroll
        for (int i = 0; i < 4; ++i) *(u32x4*)(As + (crow + 32 * i) * GS + ckc * 8) = ra[i];
#pragma unroll
        for (int i = 0; i < 8; ++i) *(u32x4*)(Bs + (crow + 32 * i) * GS + ckc * 8) = rb[i];
        __syncthreads();
        if (kt + 1 < nk) {
            ap += 64; bp += 64;
#pragma unroll
            for (int i = 0; i < 4; ++i) ra[i] = *(const u32x4*)(ap + (size_t)(32 * i) * lda);
#pragma unroll
            for (int i = 0; i < 8; ++i) rb[i] = *(const u32x4*)(bp + (size_t)(32 * i) * ldb);
        }
#pragma unroll
        for (int ks = 0; ks < 2; ++ks) {
            bf16x8 a[4];
#pragma unroll
            for (int i = 0; i < 4; ++i) a[i] = *(const bf16x8*)(As + (wm * 64 + i * 16 + lr) * GS + ks * 32 + lg * 8);
#pragma unroll
            for (int h = 0; h < 2; ++h) {
                bf16x8 b[4];
#pragma unroll
                for (int i = 0; i < 4; ++i) b[i] = *(const bf16x8*)(Bs + (wn * 128 + h * 64 + i * 16 + lr) * GS + ks * 32 + lg * 8);
#pragma unroll
                for (int i = 0; i < 4; ++i)
#pragma unroll
                    for (int j = 0; j < 4; ++j) acc[h][i][j] = MFMA16(a[i], b[j], acc[h][i][j]);
            }
        }
    }
    if constexpr (epi_whole<Epi>::value) { __syncthreads(); epi.whole(acc, m0 + wm * 64, n0 + wn * 128, lr, lg); }
    else {
        if constexpr (epi_stages<Epi>::value) __syncthreads();
        epi(acc[0], m0 + wm * 64, n0 + wn * 128, lr, lg);
        epi(acc[1], m0 + wm * 64, n0 + wn * 128 + 64, lr, lg);
    }
}
DI bool gemm_order(int it, int ntn, int& tm, int& tn) {
    const int x = blockIdx.x & 7, rank = blockIdx.x >> 3, nrank = (gridDim.x - x + 7) >> 3;
    const int li = rank + it * nrank;
    if (li >= 32 * ntn) return false;
    const int mg = li / (ntn * 8), rem = li - mg * ntn * 8;
    tn = rem >> 3; tm = x * 32 + mg * 8 + (rem & 7);
    return true;
}

struct EpiIn0 {
    const Params* p;
    DI void operator()(f32x4 (&acc)[4][4], int mbase, int nbase, int lr, int lg) const {
        const int cidx = nbase >> 6;
        if (cidx >= 41) return;
        const int b = mbase >> 14;
        if (cidx == 40) {
#pragma unroll
            for (int mi = 0; mi < 4; ++mi)
#pragma unroll
                for (int ni = 0; ni < 3; ++ni)
#pragma unroll
                    for (int j = 0; j < 4; ++j) {
                        const int row = mbase + mi * 16 + lg * 4 + j;
                        p->gates0[(size_t)row * 48 + ni * 16 + lr] = 1.0f / (1.0f + __expf(-acc[mi][ni][j]));
                    }
            return;
        }
        int c6 = -1, g = 0;
        if (cidx >= 16) { c6 = (cidx - 16) >> 2; g = (cidx - 16) & 3; }
        const bool do_rope = (c6 < 0) || c6 == 0 || c6 == 2 || c6 == 4;
        if (do_rope) {
#pragma unroll
            for (int mi = 0; mi < 4; ++mi)
#pragma unroll
                for (int j = 0; j < 4; ++j) {
                    const int s = (mbase + mi * 16 + lg * 4 + j) & (SEQ - 1);
#pragma unroll
                    for (int ni = 0; ni < 2; ++ni) {
                        const float2 cs = p->rope[s * 32 + ni * 16 + lr];
                        const float x1 = acc[mi][ni][j], x2 = acc[mi][ni + 2][j];
                        acc[mi][ni][j] = x1 * cs.x - x2 * cs.y;
                        acc[mi][ni + 2][j] = x2 * cs.x + x1 * cs.y;
                    }
                }
        }
        if (c6 < 0) {
#pragma unroll
            for (int mi = 0; mi < 4; ++mi)
#pragma unroll
                for (int ni = 0; ni < 4; ++ni)
#pragma unroll
                    for (int j = 0; j < 4; ++j) {
                        const int row = mbase + mi * 16 + lg * 4 + j;
                        p->q0[(size_t)row * 1024 + cidx * 64 + ni * 16 + lr] = f2bf(acc[mi][ni][j] * (0.125f * LOG2E));
                    }
        } else if (c6 == 3 || c6 == 5) {
            const int bg = b * 4 + g;
#pragma unroll
            for (int mi = 0; mi < 4; ++mi)
#pragma unroll
                for (int ni = 0; ni < 4; ++ni) {
                    const int s0 = (mbase + mi * 16 + lg * 4) & (SEQ - 1), d = ni * 16 + lr;
                    if (c6 == 3) {
                        *(unsigned*)((unsigned char*)p->vslcT + ((size_t)(bg * 256 + (s0 >> 6)) * 64 + d) * 64 + (s0 & 63)) = pack4_fp8(acc[mi][ni][0], acc[mi][ni][1], acc[mi][ni][2], acc[mi][ni][3]);
                    } else {
                        u32x2 w; w.x = pack2(acc[mi][ni][0], acc[mi][ni][1]); w.y = pack2(acc[mi][ni][2], acc[mi][ni][3]);
                        *(u32x2*)(p->vwinT + ((size_t)bg * 64 + d) * SEQ + s0) = w;
                    }
                }
        } else {
            bf16_t* base = (c6 == 0) ? p->kcin : (c6 == 1) ? p->vcin : (c6 == 2) ? p->kslc : p->kwin;
            const int bg = b * 4 + g;
#pragma unroll
            for (int mi = 0; mi < 4; ++mi)
#pragma unroll
                for (int ni = 0; ni < 4; ++ni)
#pragma unroll
                    for (int j = 0; j < 4; ++j) {
                        const int s = (mbase + mi * 16 + lg * 4 + j) & (SEQ - 1);
                        if (c6 == 2) ((unsigned char*)base)[((size_t)bg * SEQ + s) * 64 + ni * 16 + lr] = (unsigned char)(pack4_fp8(acc[mi][ni][j], 0.f, 0.f, 0.f) & 0xffu);
                        else base[((size_t)bg * SEQ + s) * 64 + ni * 16 + lr] = f2bf(acc[mi][ni][j]);
                    }
        }
    }
};
struct EpiIn1 {
    const Params* p;
    DI void operator()(f32x4 (&acc)[4][4], int mbase, int nbase, int lr, int lg) const {
        const int cidx = nbase >> 6;
        if (cidx >= 49) return;
        const int b = mbase >> 14;
        if (cidx == 48) {
            const float fb = p->l1_f_bias[lr];
#pragma unroll
            for (int mi = 0; mi < 4; ++mi)
#pragma unroll
                for (int j = 0; j < 4; ++j) {
                    const int s = (mbase + mi * 16 + lg * 4 + j) & (SEQ - 1);
                    const float z = acc[mi][0][j] + fb;
                    p->cfox[((size_t)(b * 16 + lr)) * SEQ + s] = (fminf(z, 0.f) - log1pf(__expf(-fabsf(z)))) * LOG2E;
                }
            return;
        }
        if (cidx < 16) {
            float mxs = 0.f;
#pragma unroll
            for (int mi = 0; mi < 4; ++mi)
#pragma unroll
                for (int j = 0; j < 4; ++j) {
                    const int row = mbase + mi * 16 + lg * 4 + j;
                    float ss = 0.f;
#pragma unroll
                    for (int ni = 0; ni < 4; ++ni) {
                        const bf16_t hv = f2bf(acc[mi][ni][j] * (0.125f * LOG2E));
                        p->q1[(size_t)row * 1024 + cidx * 64 + ni * 16 + lr] = hv;
                        const float r = __uint_as_float((unsigned)hv << 16); ss += r * r;
                    }
                    ss = octet_sum(ss); ss += dppf<0x128>(ss);
                    mxs = fmaxf(mxs, ss);
                }
            mxs = xrow16_max(mxs);
            if ((threadIdx.x & 63) == 0) atomicMax(&p->nrm[(b * 16 + cidx) * 2 + 1], __float_as_uint(mxs * 1.02f));
        } else if (cidx < 32) {
            const int bh = b * 16 + (cidx - 16);
            float mxs = 0.f;
#pragma unroll
            for (int mi = 0; mi < 4; ++mi)
#pragma unroll
                for (int j = 0; j < 4; ++j) {
                    const int s = (mbase + mi * 16 + lg * 4 + j) & (SEQ - 1);
                    float ss = 0.f;
#pragma unroll
                    for (int ni = 0; ni < 4; ++ni) {
                        const bf16_t hv = f2bf(acc[mi][ni][j]);
                        p->k1[((size_t)bh * SEQ + s) * 64 + ni * 16 + lr] = hv;
                        const float r = __uint_as_float((unsigned)hv << 16); ss += r * r;
                    }
                    ss = octet_sum(ss); ss += dppf<0x128>(ss);
                    mxs = fmaxf(mxs, ss);
                }
            mxs = xrow16_max(mxs);
            if ((threadIdx.x & 63) == 0) atomicMax(&p->nrm[bh * 2], __float_as_uint(mxs * 1.02f));
        } else {
            const int bh = b * 16 + (cidx - 32);
#pragma unroll
            for (int mi = 0; mi < 4; ++mi)
#pragma unroll
                for (int ni = 0; ni < 4; ++ni) {
                    const int s0 = (mbase + mi * 16 + lg * 4) & (SEQ - 1), d = ni * 16 + lr;
                    u32x2 w; w.x = pack2(acc[mi][ni][0], acc[mi][ni][1]); w.y = pack2(acc[mi][ni][2], acc[mi][ni][3]);
                    *(u32x2*)(p->v1T + ((size_t)bh * 64 + d) * SEQ + s0) = w;
                }
        }
    }
};
DI bf16_t* res_row(float* out, size_t t) { return (bf16_t*)out + t * 2048 + 1024; }
DI const bf16_t* res_row(const float* out, size_t t) { return (const bf16_t*)out + t * 2048 + 1024; }
constexpr int EST = 68;
template <bool RES16>
struct EpiResid {
    static constexpr bool STAGE = true;
    const float* res; float* out; float* stg;
    DI void operator()(f32x4 (&acc)[4][4], int mbase, int nbase, int lr, int lg) const {
        const int lane = threadIdx.x & 63, r4 = lane >> 4, c4 = (lane & 15) * 4;
        float* s = stg + (threadIdx.x >> 6) * (64 * EST);
#pragma unroll
        for (int mi = 0; mi < 4; ++mi)
#pragma unroll
            for (int ni = 0; ni < 4; ++ni)
#pragma unroll
                for (int j = 0; j < 4; ++j) s[(mi * 16 + lg * 4 + j) * EST + ni * 16 + lr] = acc[mi][ni][j];
#pragma unroll
        for (int g8 = 0; g8 < 2; ++g8) {
            f32x4 rr[8];
#pragma unroll
            for (int k = 0; k < 8; ++k) {
                const int row = (g8 * 8 + k) * 4 + r4;
                if (RES16) { const u32x2 w = *(const u32x2*)(res_row(res, (size_t)(mbase + row)) + nbase + c4); rr[k] = (f32x4){bflo(w.x), bfhi(w.x), bflo(w.y), bfhi(w.y)}; }
                else rr[k] = *(const f32x4*)(res + (size_t)(mbase + row) * 1024 + nbase + c4);
            }
#pragma unroll
            for (int k = 0; k < 8; ++k) {
                const int row = (g8 * 8 + k) * 4 + r4;
                const f32x4 v = *(const f32x4*)(s + row * EST + c4);
                const f32x4 y = rr[k] + v;
                u32x2 o; o.x = pack2(y[0], y[1]); o.y = pack2(y[2], y[3]);
                *(u32x2*)(res_row(out, (size_t)(mbase + row)) + nbase + c4) = o;
            }
        }
    }
};
struct EpiF32 {
    float* out; int ld;
    DI void operator()(f32x4 (&acc)[4][4], int mbase, int nbase, int lr, int lg) const {
#pragma unroll
        for (int mi = 0; mi < 4; ++mi)
#pragma unroll
            for (int ni = 0; ni < 4; ++ni)
#pragma unroll
                for (int j = 0; j < 4; ++j) out[(size_t)(mbase + mi * 16 + lg * 4 + j) * ld + nbase + ni * 16 + lr] = acc[mi][ni][j];
    }
};
struct EpiTopk {
    static constexpr bool WHOLE = true;
    int* eidx; float* stg;
    DI void whole(const f32x4 (&acc)[2][4][4], int mbase, int nbase, int lr, int lg) const {
        const int lane = threadIdx.x & 63;
        float* s = stg + (threadIdx.x >> 6) * (64 * EST);
        unsigned tk[16];
#pragma unroll
        for (int i = 0; i < 16; ++i) tk[i] = 0u;
#pragma unroll
        for (int h = 0; h < 2; ++h) {
#pragma unroll
            for (int mi = 0; mi < 4; ++mi)
#pragma unroll
                for (int ni = 0; ni < 4; ++ni)
#pragma unroll
                    for (int j = 0; j < 4; ++j) s[(mi * 16 + lg * 4 + j) * EST + ni * 16 + lr] = acc[h][mi][ni][j];
#pragma unroll
            for (int c = 0; c < 64; c += 16) {
                unsigned ck[16];
#pragma unroll
                for (int q = 0; q < 4; ++q) {
                    const f32x4 v = *(const f32x4*)(s + lane * EST + c + 4 * q);
#pragma unroll
                    for (int e = 0; e < 4; ++e) ck[4 * q + e] = (ordf(v[e]) & 0xffffff80u) | (unsigned)(127 - (64 * h + c + 4 * q + e));
                }
                sort16_desc(ck);
                merge16_desc(tk, ck);
            }
        }
#pragma unroll
        for (int i = 0; i < 16; ++i) { s[lane * EST + i] = unordf(tk[i] & 0xffffff80u); s[lane * EST + 16 + i] = __int_as_float(127 - (int)(tk[i] & 127u)); }
        __syncthreads();
        {
            const int wid = threadIdx.x >> 6, r = 32 * (wid & 1) + (lane >> 1), q = lane & 1;
            const float* sa = stg + (wid & ~1) * (64 * EST) + r * EST;
            const float* sb = sa + 64 * EST;
            float av[16], bv[16];
#pragma unroll
            for (int i = 0; i < 16; ++i) { av[i] = sa[i]; bv[i] = sb[i]; }
            unsigned c0[16], c1[16];
#pragma unroll
            for (int i = 0; i < 16; ++i) c1[i] = 0u;
            {
                int c = 0, pi = 0, pj = 0;
#pragma unroll
                for (int i = 0; i < 16; ++i)
#pragma unroll
                    for (int j = 0; j < 16; ++j)
                        if ((i + 1) * (j + 1) <= 16) {
                            if (c & 1) {
                                const float v = q ? (av[i] + bv[j]) : (av[pi] + bv[pj]);
                                const unsigned pos = q ? (unsigned)(255 - (i * 16 + j)) : (unsigned)(255 - (pi * 16 + pj));
                                const unsigned key = (ordf(v) & 0xffffff00u) | pos;
                                const int k = c >> 1;
                                if (k < 16) c0[k] = key; else c1[k - 16] = key;
                            } else { pi = i; pj = j; }
                            ++c;
                        }
            }
            sort16_desc(c0); sort16_desc(c1); merge16_desc(c0, c1);
            unsigned pk[16];
#pragma unroll
            for (int i = 0; i < 16; ++i) pk[i] = (unsigned)__builtin_amdgcn_update_dpp(0, (int)c0[i], 0xB1, 0xF, 0xF, true);
            merge16_desc(c0, pk);
            const float smax = unordf(c0[0] & 0xffffff00u);
            float e[16], se = 0.f;
#pragma unroll
            for (int k = 0; k < 16; ++k) { e[k] = __expf(unordf(c0[k] & 0xffffff00u) - smax); se += e[k]; }
            const float inv = 1.0f / se;
            const size_t ob = ((size_t)(mbase + r) * 8 + (nbase >> 8)) * 16 + 8 * q;
            const unsigned qm = q ? 0xffffffffu : 0u;
            int ew[8];
#pragma unroll
            for (int m = 0; m < 8; ++m) {
                const unsigned key = (c0[m] & ~qm) | (c0[8 + m] & qm);
                const float g = __uint_as_float((__float_as_uint(e[m]) & ~qm) | (__float_as_uint(e[8 + m]) & qm)) * inv;
                const int pos = 255 - (int)(key & 255u), i = pos >> 4, j = pos & 15;
                const int ex = __float_as_int(sa[16 + i]) * 128 + __float_as_int(sb[16 + j]);
                ew[m] = (int)(((unsigned)f2bf(g) << 16) | (unsigned)ex);
            }
            *(i32x4*)(eidx + ob) = (i32x4){ew[0], ew[1], ew[2], ew[3]};
            *(i32x4*)(eidx + ob + 4) = (i32x4){ew[4], ew[5], ew[6], ew[7]};
        }
    }
};
struct EpiBf16 {
    bf16_t* out; int ld;
    DI void operator()(f32x4 (&acc)[4][4], int mbase, int nbase, int lr, int lg) const {
#pragma unroll
        for (int mi = 0; mi < 4; ++mi)
#pragma unroll
            for (int ni = 0; ni < 4; ++ni)
#pragma unroll
                for (int j = 0; j < 4; ++j) out[(size_t)(mbase + mi * 16 + lg * 4 + j) * ld + nbase + ni * 16 + lr] = f2bf(acc[mi][ni][j]);
    }
};
struct EpiCmp1 {
    bf16_t* out; const float* bias;
    DI void operator()(f32x4 (&acc)[4][4], int mbase, int nbase, int lr, int lg) const {
#pragma unroll
        for (int ni = 0; ni < 4; ++ni) {
            float bv = 0.f;
#pragma unroll
            for (int ksl = 0; ksl < 16; ++ksl) bv += bias[ksl * 1024 + nbase + ni * 16 + lr];
#pragma unroll
            for (int mi = 0; mi < 4; ++mi)
#pragma unroll
                for (int j = 0; j < 4; ++j) out[(size_t)(mbase + mi * 16 + lg * 4 + j) * 128 + nbase + ni * 16 + lr] = f2bf(gelu_tanh(acc[mi][ni][j] + bv));
        }
    }
};
struct EpiCmp2 {
    bf16_t* kc; bf16_t* vt; int kv;
    DI void operator()(f32x4 (&acc)[4][4], int mbase, int nbase, int lr, int lg) const {
        if (nbase >= 64) return;
#pragma unroll
        for (int mi = 0; mi < 4; ++mi)
#pragma unroll
            for (int ni = 0; ni < 4; ++ni) {
                const int c0 = mbase + mi * 16 + lg * 4, d = ni * 16 + lr;
                float v[4];
#pragma unroll
                for (int j = 0; j < 4; ++j) v[j] = (c0 + j < 1023) ? acc[mi][ni][j] : 0.f;
                if (kv == 0) {
#pragma unroll
                    for (int j = 0; j < 4; ++j) kc[(size_t)(c0 + j) * 64 + d] = f2bf(v[j]);
                } else {
                    u32x2 w; w.x = pack2(v[0], v[1]); w.y = pack2(v[2], v[3]);
                    *(u32x2*)(vt + (size_t)d * 1024 + c0) = w;
                }
            }
    }
};

DI void transpose_cvt(const float* __restrict__ in, int K, int N, int Npad, bf16_t* __restrict__ out, int gtid, int gsz) {
    const int total = Npad * (K >> 3);
    for (int idx = gtid; idx < total; idx += gsz) {
        const int n = idx % Npad, k8 = idx / Npad;
        u32x4 w = (u32x4){0u, 0u, 0u, 0u};
        if (n < N) {
            float v[8];
#pragma unroll
            for (int i = 0; i < 8; ++i) v[i] = in[(size_t)(k8 * 8 + i) * N + n];
            w.x = pack2(v[0], v[1]); w.y = pack2(v[2], v[3]); w.z = pack2(v[4], v[5]); w.w = pack2(v[6], v[7]);
        }
        *(u32x4*)(out + (size_t)n * K + k8 * 8) = w;
    }
}
DI void convert_bf16(const float* __restrict__ in, bf16_t* __restrict__ out, size_t n, int gtid, int gsz) {
    const size_t n8 = n >> 3;
    for (size_t i = gtid; i < n8; i += gsz) {
        const f32x4 a = *(const f32x4*)(in + i * 8), b = *(const f32x4*)(in + i * 8 + 4);
        u32x4 w; w.x = pack2(a[0], a[1]); w.y = pack2(a[2], a[3]); w.z = pack2(b[0], b[1]); w.w = pack2(b[2], b[3]);
        *(u32x4*)(out + i * 8) = w;
    }
}
constexpr float U8_SCALE = 512.0f, X8_SCALE = 16.0f;
DI unsigned pack4_i8(float a, float b, float c, float d, float scale) {
    int v0 = (int)__builtin_rintf(a * scale), v1 = (int)__builtin_rintf(b * scale), v2 = (int)__builtin_rintf(c * scale), v3 = (int)__builtin_rintf(d * scale);
    v0 = v0 < -127 ? -127 : (v0 > 127 ? 127 : v0); v1 = v1 < -127 ? -127 : (v1 > 127 ? 127 : v1);
    v2 = v2 < -127 ? -127 : (v2 > 127 ? 127 : v2); v3 = v3 < -127 ? -127 : (v3 > 127 ? 127 : v3);
    return (unsigned)(v0 & 255) | ((unsigned)(v1 & 255) << 8) | ((unsigned)(v2 & 255) << 16) | ((unsigned)v3 << 24);
}
DI void convert_tables_fp8(const float* __restrict__ u, const float* __restrict__ v, unsigned char* __restrict__ u8, unsigned char* __restrict__ v8s, int gtid, int gsz) {
    for (int idx = gtid; idx < 16384 * 64; idx += gsz) {
        const int e = idx >> 6, c = idx & 63;
        const float* up = u + (size_t)e * 1024 + c * 16;
        const float* vp = v + (size_t)e * 1024 + c * 16;
        u32x4 wu, wv;
#pragma unroll
        for (int q = 0; q < 4; ++q) {
            const f32x4 a = *(const f32x4*)(up + 4 * q), b = *(const f32x4*)(vp + 4 * q) * FP8_SCALE;
            wu[q] = pack4_i8(a[0], a[1], a[2], a[3], U8_SCALE); wv[q] = pack4_fp8(b[0], b[1], b[2], b[3]);
        }
        *(u32x4*)(u8 + (size_t)e * 1024 + c * 16) = wu;
        *(u32x4*)(v8s + ((size_t)(c >> 3) * 16384 + e) * 128 + (c & 7) * 16) = wv;
    }
}
DI void rmsnorm_rows(const float* in, const float* gain, bf16_t* outb, float* outf) {
    const int lane = threadIdx.x & 63, gw = (blockIdx.x * blockDim.x + threadIdx.x) >> 6, nw = (gridDim.x * blockDim.x) >> 6;
    for (int row = gw; row < NTOK; row += nw) {
        const float* xr = in + (size_t)row * 1024;
        f32x4 v[4]; float ss = 0.f;
#pragma unroll
        for (int i = 0; i < 4; ++i) { v[i] = *(const f32x4*)(xr + i * 256 + lane * 4); ss += v[i][0] * v[i][0] + v[i][1] * v[i][1] + v[i][2] * v[i][2] + v[i][3] * v[i][3]; }
#pragma unroll
        for (int off = 32; off >= 1; off >>= 1) ss += __shfl_xor(ss, off);
        const float rs = rsqrtf(ss * (1.0f / 1024.0f) + 1e-6f);
#pragma unroll
        for (int i = 0; i < 4; ++i) {
            const f32x4 g = *(const f32x4*)(gain + i * 256 + lane * 4);
            const f32x4 y = v[i] * rs * g;
            if (outb) { u32x2 w; w.x = pack2(y[0], y[1]); w.y = pack2(y[2], y[3]); *(u32x2*)(outb + (size_t)row * 1024 + i * 256 + lane * 4) = w; }
            else *(f32x4*)(outf + (size_t)row * 1024 + i * 256 + lane * 4) = y;
        }
    }
}

DI void rmsnorm_rows_q8(const float* in, const float* gain, bf16_t* outb, unsigned char* out8) {
    const int lane = threadIdx.x & 63, gw = (blockIdx.x * blockDim.x + threadIdx.x) >> 6, nw = (gridDim.x * blockDim.x) >> 6;
    for (int row = gw; row < NTOK; row += nw) {
        const float* xr = in + (size_t)row * 1024;
        f32x4 v[4]; float ss = 0.f;
#pragma unroll
        for (int i = 0; i < 4; ++i) { v[i] = *(const f32x4*)(xr + i * 256 + lane * 4); ss += v[i][0] * v[i][0] + v[i][1] * v[i][1] + v[i][2] * v[i][2] + v[i][3] * v[i][3]; }
#pragma unroll
        for (int off = 32; off >= 1; off >>= 1) ss += __shfl_xor(ss, off);
        const float rs = rsqrtf(ss * (1.0f / 1024.0f) + 1e-6f);
#pragma unroll
        for (int i = 0; i < 4; ++i) {
            const f32x4 g = *(const f32x4*)(gain + i * 256 + lane * 4);
            const f32x4 y = v[i] * rs * g;
            u32x2 w; w.x = pack2(y[0], y[1]); w.y = pack2(y[2], y[3]);
            *(u32x2*)(outb + (size_t)row * 1024 + i * 256 + lane * 4) = w;
            *(unsigned*)(out8 + (size_t)row * 1024 + i * 256 + lane * 4) = pack4_i8(y[0], y[1], y[2], y[3], X8_SCALE);
        }
    }
}
template <int MODE, bool IN16 = false>
DI void rmsnorm_pipe(const float* in, const float* gain, bf16_t* outb, float* outf, unsigned char* out8) {
    const int lane = threadIdx.x & 63, gw = (blockIdx.x * blockDim.x + threadIdx.x) >> 6, nw = (gridDim.x * blockDim.x) >> 6;
    f32x4 g[4];
#pragma unroll
    for (int i = 0; i < 4; ++i) g[i] = *(const f32x4*)(gain + i * 256 + lane * 4);
    int row = gw;
    f32x4 nv[4];
#pragma unroll
    for (int i = 0; i < 4; ++i) nv[i] = (f32x4){0.f, 0.f, 0.f, 0.f};
    auto ldrow = [&](int rr, int i) __attribute__((always_inline)) -> f32x4 {
        if (IN16) { const u32x2 w = *(const u32x2*)(res_row(in, (size_t)rr) + i * 256 + lane * 4); return (f32x4){bflo(w.x), bfhi(w.x), bflo(w.y), bfhi(w.y)}; }
        return *(const f32x4*)(in + (size_t)rr * 1024 + i * 256 + lane * 4);
    };
    if (row < NTOK) {
#pragma unroll
        for (int i = 0; i < 4; ++i) nv[i] = ldrow(row, i);
    }
    for (; row < NTOK; row += nw) {
        f32x4 v[4];
#pragma unroll
        for (int i = 0; i < 4; ++i) v[i] = nv[i];
        if (row + nw < NTOK) {
#pragma unroll
            for (int i = 0; i < 4; ++i) nv[i] = ldrow(row + nw, i);
        }
        float ss = 0.f;
#pragma unroll
        for (int i = 0; i < 4; ++i) ss += v[i][0] * v[i][0] + v[i][1] * v[i][1] + v[i][2] * v[i][2] + v[i][3] * v[i][3];
        ss = octet_sum(ss);
        ss = xrow16_sum(dppf<0x128>(ss) + ss);
        const float rs = rsqrtf(ss * (1.0f / 1024.0f) + 1e-6f);
#pragma unroll
        for (int i = 0; i < 4; ++i) {
            const f32x4 y = v[i] * rs * g[i];
            if (MODE == 2) *(f32x4*)(outf + (size_t)row * 1024 + i * 256 + lane * 4) = y;
            else { u32x2 w; w.x = pack2(y[0], y[1]); w.y = pack2(y[2], y[3]); *(u32x2*)(outb + (size_t)row * 1024 + i * 256 + lane * 4) = w; }
            if (MODE == 1) *(unsigned*)(out8 + (size_t)row * 1024 + i * 256 + lane * 4) = pack4_i8(y[0], y[1], y[2], y[3], X8_SCALE);
        }
    }
}
DI void phase_prologue(const Params& p) {
    const int gtid = blockIdx.x * blockDim.x + threadIdx.x, gsz = gridDim.x * blockDim.x;
    for (int idx = gtid; idx < SEQ * 32; idx += gsz) {
        const int s = idx >> 5, i = idx & 31;
        const float inv = powf(10000.0f, -(float)i / 32.0f);
        const float ang = (float)s * inv;
        float sn, cs; sincosf(ang, &sn, &cs);
        p.rope[idx] = make_float2(cs, sn);
    }
    transpose_cvt(p.l0_w_in, 1024, NSA_N, NSA_NP, p.wt_in0, gtid, gsz);
    transpose_cvt(p.l0_w_out, 1024, 1024, 1024, p.wt_out0, gtid, gsz);
    transpose_cvt(p.l1_w_in, 1024, FOX_N, FOX_NP, p.wt_in1, gtid, gsz);
    transpose_cvt(p.l1_w_out, 1024, 1024, 1024, p.wt_out1, gtid, gsz);
    for (int kv = 0; kv < 2; ++kv)
        for (int g = 0; g < 4; ++g) {
            transpose_cvt((kv ? p.l0_w1_v : p.l0_w1_k) + (size_t)g * 2048 * 128, 2048, 128, 128, p.w1t + (size_t)(kv * 4 + g) * 128 * 2048, gtid, gsz);
            transpose_cvt((kv ? p.l0_w2_v : p.l0_w2_k) + (size_t)g * 128 * 64, 128, 64, 128, p.w2t + (size_t)(kv * 4 + g) * 128 * 128, gtid, gsz);
        }
    convert_bf16(p.l0_wq, p.wq0b, (size_t)1024 * 2048, gtid, gsz);
    convert_bf16(p.l1_wq, p.wq1b, (size_t)1024 * 2048, gtid, gsz);
    convert_bf16(p.l0_keys, p.keys0b, (size_t)16 * 128 * 128, gtid, gsz);
    convert_bf16(p.l1_keys, p.keys1b, (size_t)16 * 128 * 128, gtid, gsz);
    convert_tables_fp8(p.l0_u, p.l0_v, p.u8, p.v8s, gtid, gsz);
    {
        const int lane = threadIdx.x & 63, gw = gtid >> 6, nw = gsz >> 6;
        for (int item = gw; item < 16 * 16; item += nw) {
            const int out = item >> 4, ksl = item & 15, kv = out >> 3, g = (out >> 1) & 3, h = (out & 1) * 64 + lane;
            const float* pe = (kv ? p.l0_pe_v : p.l0_pe_k) + g * 2048 + ksl * 128;
            const float* w1 = (kv ? p.l0_w1_v : p.l0_w1_k) + (size_t)g * 2048 * 128 + (size_t)ksl * 128 * 128 + h;
            float s0 = 0.f, s1 = 0.f, s2 = 0.f, s3 = 0.f;
            for (int kk = 0; kk < 128; kk += 4) {
                s0 += pe[kk] * w1[(size_t)kk * 128]; s1 += pe[kk + 1] * w1[(size_t)(kk + 1) * 128];
                s2 += pe[kk + 2] * w1[(size_t)(kk + 2) * 128]; s3 += pe[kk + 3] * w1[(size_t)(kk + 3) * 128];
            }
            p.b1[ksl * 1024 + (kv * 4 + g) * 128 + h] = (s0 + s1) + (s2 + s3);
        }
    }
    rmsnorm_pipe<0>(p.x, p.l0_attn_norm, p.xn, nullptr, nullptr);
}

DI void phase_gemm_in0(const Params& p, char* smem) {
    bf16_t* As = (bf16_t*)smem; bf16_t* Bs = As + 128 * GS;
    EpiIn0 e0{&p};
    { int tm, tn; for (int it = 0; gemm_order(it, 10, tm, tn); ++it) gemm_tile_w(p.xn, 1024, p.wt_in0, 1024, 1024, tm * 128, tn * 256, e0, As, Bs); }
    for (int t = blockIdx.x; t < NTOK / 128; t += gridDim.x) gemm_tile(p.xn, 1024, p.wt_in0, 1024, 1024, t * 128, 2560, e0, As, Bs);
    for (int t = blockIdx.x; t < 256; t += gridDim.x) {
        const int layer = t >> 7, hp = (t >> 3) & 15, nt = t & 7;
        EpiBf16 e{(layer ? p.weff1 : p.weff0) + (size_t)hp * 128 * 1024, 1024};
        gemm_tile((layer ? p.keys1b : p.keys0b) + (size_t)hp * 16384, 128, (layer ? p.wq1b : p.wq0b) + hp * 128, 2048, 128, 0, nt * 128, e, As, Bs);
    }
}
DI void phase_gemm_in1(const Params& p, char* smem) {
    bf16_t* As = (bf16_t*)smem; bf16_t* Bs = As + 128 * GS;
    EpiIn1 e1{&p};
    int tm, tn; for (int it = 0; gemm_order(it, 12, tm, tn); ++it) gemm_tile_w(p.xn, 1024, p.wt_in1, 1024, 1024, tm * 128, tn * 256, e1, As, Bs);
    for (int t = blockIdx.x; t < NTOK / 128; t += gridDim.x) gemm_tile(p.xn, 1024, p.wt_in1, 1024, 1024, t * 128, 3072, e1, As, Bs);
}
template <bool RES16>
DI void phase_gemm_out(const bf16_t* o, const bf16_t* wt, const float* res, float* out, char* smem) {
    bf16_t* As = (bf16_t*)smem; bf16_t* Bs = As + 128 * GS;
    EpiResid<RES16> e{res, out, (float*)smem};
    int tm, tn; for (int it = 0; gemm_order(it, 4, tm, tn); ++it) gemm_tile_w(o, 1024, wt, 1024, 1024, tm * 128, tn * 256, e, As, Bs);
}
DI void phase_gemm_scores(const Params& p, const bf16_t* weff, char* smem) {
    bf16_t* As = (bf16_t*)smem; bf16_t* Bs = As + 128 * GS;
    EpiTopk e{p.eidx, (float*)smem};
    int tm, tn; for (int it = 0; gemm_order(it, 8, tm, tn); ++it) gemm_tile_w(p.xn, 1024, weff, 1024, 1024, tm * 128, tn * 256, e, As, Bs);
}
DI void phase_cmp1(const Params& p, char* smem) {
    bf16_t* As = (bf16_t*)smem; bf16_t* Bs = As + 128 * GS;
    for (int t = blockIdx.x; t < 128; t += gridDim.x) {
        const int q = t >> 3, mt = t & 7, kv = q >> 3, bg = q & 7, g = bg & 3;
        EpiCmp1 e{p.hid + (size_t)q * 1024 * 128, p.b1 + (kv * 4 + g) * 128};
        gemm_tile((kv ? p.vcin : p.kcin) + (size_t)bg * SEQ * 64, 1024, p.w1t + (size_t)(kv * 4 + g) * 128 * 2048, 2048, 2048, mt * 128, 0, e, As, Bs);
    }
}
DI void phase_cmp2(const Params& p, char* smem) {
    bf16_t* As = (bf16_t*)smem; bf16_t* Bs = As + 128 * GS;
    for (int t = blockIdx.x; t < 128; t += gridDim.x) {
        const int q = t >> 3, mt = t & 7, kv = q >> 3, bg = q & 7, g = bg & 3;
        EpiCmp2 e{p.kcmp + (size_t)bg * 1024 * 64, p.vcmpT + (size_t)bg * 64 * 1024, kv};
        gemm_tile(p.hid + (size_t)q * 1024 * 128, 128, p.w2t + (size_t)(kv * 4 + g) * 128 * 128, 128, 128, mt * 128, 0, e, As, Bs);
    }
}

constexpr int KS = 72;
DI int crow16(int reg, int hh) { return (reg & 3) + 8 * (reg >> 2) + 4 * hh; }
DI void tile_ld(const bf16_t* __restrict__ g, size_t row_stride, u32x4 (&r)[2]) {
#pragma unroll
    for (int i = 0; i < 2; ++i) { const int id = threadIdx.x + 256 * i; r[i] = *(const u32x4*)(g + (size_t)(id >> 3) * row_stride + (id & 7) * 8); }
}
DI void tile_st(bf16_t* l, const u32x4 (&r)[2]) {
#pragma unroll
    for (int i = 0; i < 2; ++i) { const int id = threadIdx.x + 256 * i; *(u32x4*)(l + (id >> 3) * KS + (id & 7) * 8) = r[i]; }
}
DI void qk_tile(const bf16_t* Ks, const bf16x8 (&qf)[4], f32x16 (&S)[2], int l31, int hh) {
    bf16x8 a[2][4];
#pragma unroll
    for (int kb = 0; kb < 2; ++kb)
#pragma unroll
        for (int ks = 0; ks < 4; ++ks) a[kb][ks] = *(const bf16x8*)(Ks + (32 * kb + l31) * KS + 16 * ks + 8 * hh);
#pragma unroll
    for (int kb = 0; kb < 2; ++kb) {
#pragma unroll
        for (int i = 0; i < 16; ++i) S[kb][i] = 0.f;
#pragma unroll
        for (int ks = 0; ks < 4; ++ks) S[kb] = MFMA32(a[kb][ks], qf[ks], S[kb]);
    }
}
DI void pv_tile(const bf16_t* Vs, const f32x16 (&P)[2], f32x16 (&O)[2], int l31, int hh) {
#pragma unroll
    for (int kb = 0; kb < 2; ++kb) {
        s16x4 lo[2][2], hi[2][2];
#pragma unroll
        for (int s = 0; s < 2; ++s)
#pragma unroll
            for (int db = 0; db < 2; ++db) {
                const bf16_t* vp = Vs + (32 * db + l31) * KS + 32 * kb + 16 * s + 4 * hh;
                lo[s][db] = *(const s16x4*)vp; hi[s][db] = *(const s16x4*)(vp + 8);
            }
#pragma unroll
        for (int s = 0; s < 2; ++s) {
            u32x4 pw;
            pw.x = pack2(P[kb][8 * s + 0], P[kb][8 * s + 1]); pw.y = pack2(P[kb][8 * s + 2], P[kb][8 * s + 3]);
            pw.z = pack2(P[kb][8 * s + 4], P[kb][8 * s + 5]); pw.w = pack2(P[kb][8 * s + 6], P[kb][8 * s + 7]);
            const bf16x8 pf = __builtin_bit_cast(bf16x8, pw);
#pragma unroll
            for (int db = 0; db < 2; ++db) {
                const bf16x8 a = __builtin_shufflevector(lo[s][db], hi[s][db], 0, 1, 2, 3, 4, 5, 6, 7);
                O[db] = MFMA32(a, pf, O[db]);
            }
        }
    }
}
DI void softmax_update(f32x16 (&S)[2], f32x16 (&O)[2], float& m, float& l) {
    float mx = NEGINF;
#pragma unroll
    for (int kb = 0; kb < 2; ++kb)
#pragma unroll
        for (int i = 0; i < 16; ++i) mx = fmaxf(mx, S[kb][i]);
    mx = fmaxf(mx, __shfl_xor(mx, 32));
    const float mnew = fmaxf(m, mx);
    const float msafe = (mnew == NEGINF) ? 0.f : mnew;
    const float alpha = __builtin_amdgcn_exp2f(m - msafe);
    float rs = 0.f;
#pragma unroll
    for (int kb = 0; kb < 2; ++kb)
#pragma unroll
        for (int i = 0; i < 16; ++i) { const float pv = __builtin_amdgcn_exp2f(S[kb][i] - msafe); S[kb][i] = pv; rs += pv; }
    l = l * alpha + rs; m = mnew;
#pragma unroll
    for (int db = 0; db < 2; ++db)
#pragma unroll
        for (int i = 0; i < 16; ++i) O[db][i] *= alpha;
}

DI void softmax_update_lazy(f32x16 (&S)[2], f32x16 (&O)[2], float& m, float& l) {
    float mx = NEGINF;
#pragma unroll
    for (int kb = 0; kb < 2; ++kb)
#pragma unroll
        for (int i = 0; i < 16; ++i) mx = fmaxf(mx, S[kb][i]);
    mx = xhalf_max(mx);
    if (__any(mx > m + 8.0f)) {
        const float mnew = fmaxf(m, mx), ms = (mnew == NEGINF) ? 0.f : mnew;
        const float alpha = __builtin_amdgcn_exp2f(m - ms);
        l *= alpha; m = mnew;
#pragma unroll
        for (int db = 0; db < 2; ++db)
#pragma unroll
            for (int i = 0; i < 16; ++i) O[db][i] *= alpha;
    }
    const float msafe = (m == NEGINF) ? 0.f : m;
    float rs = 0.f;
#pragma unroll
    for (int kb = 0; kb < 2; ++kb)
#pragma unroll
        for (int i = 0; i < 16; ++i) { const float pv = __builtin_amdgcn_exp2f(S[kb][i] - msafe); S[kb][i] = pv; rs += pv; }
    l += rs;
}
DI void softmax_update_rel(f32x16 (&S)[2], f32x16 (&O)[2], float& m, float& l, float& mtrue) {
    float mx = NEGINF;
#pragma unroll
    for (int kb = 0; kb < 2; ++kb)
#pragma unroll
        for (int i = 0; i < 16; ++i) mx = fmaxf(mx, S[kb][i]);
    mx = xhalf_max(mx);
    mtrue = fmaxf(mtrue, mx + ((m == NEGINF) ? 0.f : m));
    if (__any((m == NEGINF) ? (mx != NEGINF) : (mx > 8.0f))) {
        const float mold = (m == NEGINF) ? 0.f : m;
        const float mnew = fmaxf(m, mx + mold), msn = (mnew == NEGINF) ? 0.f : mnew;
        const float alpha = __builtin_amdgcn_exp2f(m - msn), delta = msn - mold;
        l *= alpha; m = mnew;
#pragma unroll
        for (int db = 0; db < 2; ++db)
#pragma unroll
            for (int i = 0; i < 16; ++i) O[db][i] *= alpha;
#pragma unroll
        for (int kb = 0; kb < 2; ++kb)
#pragma unroll
            for (int i = 0; i < 16; ++i) S[kb][i] -= delta;
    }
    float rs = 0.f;
#pragma unroll
    for (int kb = 0; kb < 2; ++kb)
#pragma unroll
        for (int i = 0; i < 16; ++i) { const float pv = __builtin_amdgcn_exp2f(S[kb][i]); S[kb][i] = pv; rs += pv; }
    l += rs;
}
DI void phase_fox(const Params& p, char* smem) {
    bf16_t* T2 = (bf16_t*)smem;
    float* cks = (float*)(T2 + 4 * 64 * KS); int* ktmin = (int*)(cks + 128); int* wdone = ktmin + 4;
    const int tid = threadIdx.x, lane = tid & 63, wid = tid >> 6, l31 = lane & 31, hh = lane >> 5;
    for (int u = blockIdx.x; u < 4096; u += gridDim.x) {
        const int qt = 127 - (u >> 5), bh = u & 31, b = bh >> 4, h = bh & 15;
        const int t0 = qt * 128, tw = t0 + 32 * wid, tq = tw + l31;
        const bf16_t* Kg = p.k1 + (size_t)bh * SEQ * 64;
        const bf16_t* Vg = p.v1T + (size_t)bh * 64 * SEQ;
        const float* cg = p.cfox + (size_t)bh * SEQ;
        const int ntile = 2 * qt + 2;
        __syncthreads();
        if (tid == 0) *ktmin = ntile - 1;
        if (tid < 4) wdone[tid] = 0;
        __syncthreads();
        {
            const float bnd = 2.0f * sqrtf(__uint_as_float(p.nrm[bh * 2]) * __uint_as_float(p.nrm[bh * 2 + 1])) + 48.0f;
            if (tid < ntile && (cg[t0] - cg[64 * tid + 63]) >= -bnd) atomicMin(ktmin, tid);
        }
        __syncthreads();
        const int kt_start = *ktmin;
        bf16x8 qf[4];
#pragma unroll
        for (int ks = 0; ks < 4; ++ks) qf[ks] = *(const bf16x8*)(p.q1 + ((size_t)(b * SEQ + tq)) * 1024 + h * 64 + 16 * ks + 8 * hh);
        const float cq = cg[tq];
        float qkb;
        {
            float s2 = 0.f;
#pragma unroll
            for (int ks = 0; ks < 4; ++ks)
#pragma unroll
                for (int i = 0; i < 8; ++i) { const float v = __uint_as_float(((unsigned)(unsigned short)qf[ks][i]) << 16); s2 += v * v; }
            s2 = xhalf_sum(s2);
            qkb = sqrtf(s2 * 1.02f * __uint_as_float(p.nrm[bh * 2]));
        }
        bool wfin = false; float mtrue = NEGINF;
        f32x16 O[2];
#pragma unroll
        for (int db = 0; db < 2; ++db)
#pragma unroll
            for (int i = 0; i < 16; ++i) O[db][i] = 0.f;
        float m = NEGINF, l = 0.f;
        const int s_hi = qt, s_lo = kt_start >> 1;
        u32x4 rk[2][2], rv[2][2]; float rc = 0.f;
#pragma unroll
        for (int q = 0; q < 2; ++q) { tile_ld(Kg + (size_t)(2 * s_hi + q) * 64 * 64, 64, rk[q]); tile_ld(Vg + (2 * s_hi + q) * 64, SEQ, rv[q]); }
        if (tid < 128) rc = cg[2 * s_hi * 64 + tid];
        for (int st = s_hi; st >= s_lo; --st) {
            __syncthreads();
            if (wdone[0] & wdone[1] & wdone[2] & wdone[3]) break;
#pragma unroll
            for (int q = 0; q < 2; ++q) { tile_st(T2 + q * 2 * 64 * KS, rk[q]); tile_st(T2 + q * 2 * 64 * KS + 64 * KS, rv[q]); }
            if (tid < 128) cks[tid] = rc;
            __syncthreads();
            if (st - 1 >= s_lo) {
#pragma unroll
                for (int q = 0; q < 2; ++q) { tile_ld(Kg + (size_t)(2 * (st - 1) + q) * 64 * 64, 64, rk[q]); tile_ld(Vg + (2 * (st - 1) + q) * 64, SEQ, rv[q]); }
                if (tid < 128) rc = cg[2 * (st - 1) * 64 + tid];
            }
#pragma unroll
            for (int qq = 0; qq < 2; ++qq) {
                const int q = 1 - qq, kt = 2 * st + q, k0 = kt * 64;
                if (kt < kt_start || k0 > tw + 31 || wfin) continue;
                if (__all(qkb + (cq - cks[64 * q + 63]) < mtrue - 48.0f)) { wfin = true; if (lane == 0) wdone[wid] = 1; continue; }
                const bf16_t* Ks = T2 + q * 2 * 64 * KS; const bf16_t* Vs = Ks + 64 * KS;
                f32x16 S[2];
                const float cqm = cq - ((m == NEGINF) ? 0.f : m);
#pragma unroll
                for (int kb = 0; kb < 2; ++kb)
#pragma unroll
                    for (int g4 = 0; g4 < 4; ++g4) {
                        const f32x4 ck = *(const f32x4*)(cks + 64 * q + 32 * kb + 8 * g4 + 4 * hh);
#pragma unroll
                        for (int j = 0; j < 4; ++j) S[kb][4 * g4 + j] = cqm - ck[j];
                    }
                {
                    bf16x8 a[2][4];
#pragma unroll
                    for (int kb = 0; kb < 2; ++kb)
#pragma unroll
                        for (int ks = 0; ks < 4; ++ks) a[kb][ks] = *(const bf16x8*)(Ks + (32 * kb + l31) * KS + 16 * ks + 8 * hh);
#pragma unroll
                    for (int kb = 0; kb < 2; ++kb)
#pragma unroll
                        for (int ks = 0; ks < 4; ++ks) S[kb] = MFMA32(a[kb][ks], qf[ks], S[kb]);
                }
                if (k0 + 63 > tw) {
#pragma unroll
                    for (int kb = 0; kb < 2; ++kb)
#pragma unroll
                        for (int i = 0; i < 16; ++i) { const int key = k0 + 32 * kb + crow16(i, hh); S[kb][i] = (key <= tq) ? S[kb][i] : NEGINF; }
                }
                softmax_update_rel(S, O, m, l, mtrue);
                pv_tile(Vs, S, O, l31, hh);
            }
        }
        l = xhalf_sum(l);
        const float inv = 1.0f / l;
        bf16_t* op = p.o1 + ((size_t)(b * SEQ + tq)) * 1024 + h * 64;
#pragma unroll
        for (int db = 0; db < 2; ++db)
#pragma unroll
            for (int g4 = 0; g4 < 4; ++g4) {
                u32x2 w; w.x = pack2(O[db][4 * g4] * inv, O[db][4 * g4 + 1] * inv); w.y = pack2(O[db][4 * g4 + 2] * inv, O[db][4 * g4 + 3] * inv);
                *(u32x2*)(op + 32 * db + 8 * g4 + 4 * hh) = w;
            }
    }
}

constexpr int IST = 257;
DI unsigned octet_max_u32(unsigned v) {
    v = max(v, (unsigned)__builtin_amdgcn_update_dpp(0, (int)v, 0xB1, 0xF, 0xF, true));
    v = max(v, (unsigned)__builtin_amdgcn_update_dpp(0, (int)v, 0x4E, 0xF, 0xF, true));
    v = max(v, (unsigned)__builtin_amdgcn_update_dpp(0, (int)v, 0x141, 0xF, 0xF, true));
    return v;
}
DI void phase_nsa_a(const Params& p, char* smem) {
    bf16_t* Ks = (bf16_t*)smem; bf16_t* Vs = Ks + 64 * KS; float* imp = (float*)(Vs + 64 * KS);
    const int tid = threadIdx.x, lane = tid & 63, wid = tid >> 6, l31 = lane & 31, hh = lane >> 5;
    for (int u = blockIdx.x; u < 4096; u += gridDim.x) {
        const int tile = 511 - (u >> 3), bg = u & 7, b = bg >> 2, g = bg & 3;
        const int hd = l31 & 3, ql8 = 8 * wid + (l31 >> 2);
        const int t0 = tile * 32, tq = t0 + ql8;
        const size_t tok = (size_t)b * SEQ + tq;
        bf16x8 qf[4];
#pragma unroll
        for (int ks = 0; ks < 4; ++ks) qf[ks] = *(const bf16x8*)(p.q0 + tok * 1024 + (g * 4 + hd) * 64 + 16 * ks + 8 * hh);
        const bf16_t* Kc = p.kcmp + (size_t)bg * 1024 * 64;
        const bf16_t* Vc = p.vcmpT + (size_t)bg * 64 * 1024;
        const int ntc = ((t0 >> 4) >> 6) + 1;
        const int call = (t0 - 31) >> 4;
        float m = NEGINF, l = 0.f;
        u32x4 rk[2], rv[2];
        tile_ld(Kc, 64, rk);
        for (int kt = 0; kt < ntc; ++kt) {
            __syncthreads();
            tile_st(Ks, rk);
            __syncthreads();
            if (kt + 1 < ntc) tile_ld(Kc + (size_t)(kt + 1) * 64 * 64, 64, rk);
            f32x16 S[2];
            qk_tile(Ks, qf, S, l31, hh);
            if (kt * 64 + 63 > call) {
#pragma unroll
                for (int kb = 0; kb < 2; ++kb)
#pragma unroll
                    for (int i = 0; i < 16; ++i) { const int c = kt * 64 + 32 * kb + crow16(i, hh); S[kb][i] = (16 * c + 31 <= tq) ? S[kb][i] : NEGINF; }
            }
            float mx = NEGINF;
#pragma unroll
            for (int kb = 0; kb < 2; ++kb)
#pragma unroll
                for (int i = 0; i < 16; ++i) mx = fmaxf(mx, S[kb][i]);
            mx = fmaxf(mx, __shfl_xor(mx, 32));
            if (__any(mx > m + 8.0f)) { const float mnew = fmaxf(m, mx), ms = (mnew == NEGINF) ? 0.f : mnew; l *= __builtin_amdgcn_exp2f(m - ms); m = mnew; }
            const float msafe = (m == NEGINF) ? 0.f : m;
            float rs = 0.f;
#pragma unroll
            for (int kb = 0; kb < 2; ++kb)
#pragma unroll
                for (int i = 0; i < 16; ++i) rs += __builtin_amdgcn_exp2f(S[kb][i] - msafe);
            l += rs;
        }
        l += __shfl_xor(l, 32);
        const float mfin = (m == NEGINF) ? 0.f : m, invl = (l > 0.f) ? 1.0f / l : 0.f;
        __syncthreads();
        f32x16 O[2];
#pragma unroll
        for (int db = 0; db < 2; ++db)
#pragma unroll
            for (int i = 0; i < 16; ++i) O[db][i] = 0.f;
        float carry = 0.f;
        tile_ld(Kc, 64, rk); tile_ld(Vc, 1024, rv);
        for (int kt = 0; kt < ntc; ++kt) {
            __syncthreads();
            tile_st(Ks, rk); tile_st(Vs, rv);
            __syncthreads();
            if (kt + 1 < ntc) { tile_ld(Kc + (size_t)(kt + 1) * 64 * 64, 64, rk); tile_ld(Vc + (kt + 1) * 64, 1024, rv); }
            f32x16 S[2];
            qk_tile(Ks, qf, S, l31, hh);
            if (kt * 64 + 63 > call) {
#pragma unroll
                for (int kb = 0; kb < 2; ++kb)
#pragma unroll
                    for (int i = 0; i < 16; ++i) { const int c = kt * 64 + 32 * kb + crow16(i, hh); S[kb][i] = (16 * c + 31 <= tq) ? S[kb][i] : NEGINF; }
            }
#pragma unroll
            for (int kb = 0; kb < 2; ++kb)
#pragma unroll
                for (int i = 0; i < 16; ++i) S[kb][i] = __builtin_amdgcn_exp2f(S[kb][i] - mfin) * invl;
            float A[2][4], P[2][4];
#pragma unroll
            for (int kb = 0; kb < 2; ++kb)
#pragma unroll
                for (int g4 = 0; g4 < 4; ++g4) {
                    float sp = 0.5f * S[kb][4 * g4 + 3];
                    float a = (S[kb][4 * g4] + S[kb][4 * g4 + 1]) + (S[kb][4 * g4 + 2] + sp);
                    a += __builtin_bit_cast(float, __builtin_amdgcn_update_dpp(0, __builtin_bit_cast(int, a), 0xB1, 0xF, 0xF, true));
                    a += __builtin_bit_cast(float, __builtin_amdgcn_update_dpp(0, __builtin_bit_cast(int, a), 0x4E, 0xF, 0xF, true));
                    sp += __builtin_bit_cast(float, __builtin_amdgcn_update_dpp(0, __builtin_bit_cast(int, sp), 0xB1, 0xF, 0xF, true));
                    sp += __builtin_bit_cast(float, __builtin_amdgcn_update_dpp(0, __builtin_bit_cast(int, sp), 0x4E, 0xF, 0xF, true));
                    const auto t = __builtin_amdgcn_permlane32_swap(__float_as_uint(sp), __float_as_uint(sp), false, false);
                    A[kb][g4] = a; P[kb][g4] = (__uint_as_float(t[0]) + __uint_as_float(t[1])) - sp;
                }
#pragma unroll
            for (int kb = 0; kb < 2; ++kb)
#pragma unroll
                for (int g4 = 0; g4 < 4; ++g4) {
                    const float prev = (g4 > 0) ? P[kb][g4 - 1] : (kb > 0 ? P[0][3] : carry);
                    const float v = A[kb][g4] + (hh ? P[kb][g4] : prev);
                    if (hd == 0) imp[ql8 * IST + 16 * kt + 8 * kb + 2 * g4 + hh] = v;
                }
            carry = P[1][3];
            pv_tile(Vs, S, O, l31, hh);
        }
        __syncthreads();
        {
            const int ql = lane >> 3, sub = lane & 7, q = 8 * wid + ql, cur = t0 >> 6, imax = cur >> 3;
            unsigned k[32];
#pragma unroll
            for (int i = 0; i < 32; ++i) {
                k[i] = 0u;
                if (i <= imax) {
                    const int j = sub + 8 * i;
                    const float v = imp[q * IST + j];
                    const bool forced = (j == 0) | (j == cur) | (j == cur - 1);
                    const float val = forced ? 1.0e4f : ((j <= cur) ? v : -1.0f);
                    k[i] = (ordf(val) & 0xffffff00u) | (unsigned)(255 - j);
                }
            }
            int s0 = 255, s1 = 255;
            for (int r = 0; r < 16; ++r) {
                unsigned best = 0u;
#pragma unroll
                for (int i = 0; i < 32; ++i) if (i <= imax) best = max(best, k[i]);
                best = octet_max_u32(best);
                const int jw = 255 - (int)(best & 255u);
                if (r == sub) s0 = jw;
                if (r == sub + 8) s1 = jw;
#pragma unroll
                for (int i = 0; i < 32; ++i) if (i <= imax) k[i] = (k[i] == best) ? 0u : k[i];
            }
            int* sp = p.sel + (((size_t)b * SEQ + t0 + q) * 4 + g) * 16;
            sp[sub] = s0; sp[8 + sub] = s1;
        }
        __syncthreads();
        float* ob = imp + (wid * 32 + l31) * 64;
        {
            const float gc = p.gates0[tok * 48 + g * 4 + hd];
#pragma unroll
            for (int db = 0; db < 2; ++db)
#pragma unroll
                for (int g4 = 0; g4 < 4; ++g4)
                    *(f32x4*)(ob + 32 * db + 8 * g4 + 4 * hh) = (f32x4){O[db][4 * g4] * gc, O[db][4 * g4 + 1] * gc, O[db][4 * g4 + 2] * gc, O[db][4 * g4 + 3] * gc};
        }
        const bf16_t* Kw = p.kwin + (size_t)bg * SEQ * 64;
        const bf16_t* Vw = p.vwinT + (size_t)bg * 64 * SEQ;
        const int lo = (t0 - 511) > 0 ? (t0 - 511) : 0;
        const int kt_lo = lo >> 6, kt_hi = (t0 + 31) >> 6;
#pragma unroll
        for (int db = 0; db < 2; ++db)
#pragma unroll
            for (int i = 0; i < 16; ++i) O[db][i] = 0.f;
        m = NEGINF; l = 0.f;
        tile_ld(Kw + (size_t)kt_hi * 64 * 64, 64, rk); tile_ld(Vw + kt_hi * 64, SEQ, rv);
        for (int kt = kt_hi; kt >= kt_lo; --kt) {
            __syncthreads();
            tile_st(Ks, rk); tile_st(Vs, rv);
            __syncthreads();
            if (kt - 1 >= kt_lo) { tile_ld(Kw + (size_t)(kt - 1) * 64 * 64, 64, rk); tile_ld(Vw + (kt - 1) * 64, SEQ, rv); }
            f32x16 S[2];
            qk_tile(Ks, qf, S, l31, hh);
            if (!(kt * 64 + 63 <= t0 && kt * 64 > t0 + 31 - 512)) {
#pragma unroll
                for (int kb = 0; kb < 2; ++kb)
#pragma unroll
                    for (int i = 0; i < 16; ++i) {
                        const int key = kt * 64 + 32 * kb + crow16(i, hh);
                        S[kb][i] = (key <= tq && key > tq - 512) ? S[kb][i] : NEGINF;
                    }
            }
            softmax_update_lazy(S, O, m, l);
            pv_tile(Vs, S, O, l31, hh);
        }
        l += __shfl_xor(l, 32);
        {
            const float gw = p.gates0[tok * 48 + 32 + g * 4 + hd] / l;
            bf16_t* op = p.o0 + tok * 1024 + (g * 4 + hd) * 64;
#pragma unroll
            for (int db = 0; db < 2; ++db)
#pragma unroll
                for (int g4 = 0; g4 < 4; ++g4) {
                    const f32x4 oc = *(const f32x4*)(ob + 32 * db + 8 * g4 + 4 * hh);
                    u32x2 w;
                    w.x = pack2(oc[0] + O[db][4 * g4] * gw, oc[1] + O[db][4 * g4 + 1] * gw);
                    w.y = pack2(oc[2] + O[db][4 * g4 + 2] * gw, oc[3] + O[db][4 * g4 + 3] * gw);
                    *(u32x2*)(op + 32 * db + 8 * g4 + 4 * hh) = w;
                }
        }
        __syncthreads();
    }
}

constexpr int NB_ST = 2;
constexpr int NB_TILE = 2 * 64 * KS;
constexpr int OST = 68;
constexpr int NSB_LDS = NB_ST * NB_TILE * 2 + 2048 + 256 + 1024 + 1024 + 256 * OST * 2 + 256 * 4 * 4;
DI void fp8_tile_st(bf16_t* l, const u32x4 r) {
    const int row = threadIdx.x >> 2, c16 = (threadIdx.x & 3) * 16;
    u32x4 w0, w1;
    { const f32x2 a = __builtin_amdgcn_cvt_pk_f32_fp8((int)r.x, false), b = __builtin_amdgcn_cvt_pk_f32_fp8((int)r.x, true); w0.x = pack2(a.x, a.y); w0.y = pack2(b.x, b.y); }
    { const f32x2 a = __builtin_amdgcn_cvt_pk_f32_fp8((int)r.y, false), b = __builtin_amdgcn_cvt_pk_f32_fp8((int)r.y, true); w0.z = pack2(a.x, a.y); w0.w = pack2(b.x, b.y); }
    { const f32x2 a = __builtin_amdgcn_cvt_pk_f32_fp8((int)r.z, false), b = __builtin_amdgcn_cvt_pk_f32_fp8((int)r.z, true); w1.x = pack2(a.x, a.y); w1.y = pack2(b.x, b.y); }
    { const f32x2 a = __builtin_amdgcn_cvt_pk_f32_fp8((int)r.w, false), b = __builtin_amdgcn_cvt_pk_f32_fp8((int)r.w, true); w1.z = pack2(a.x, a.y); w1.w = pack2(b.x, b.y); }
    *(u32x4*)(l + row * KS + c16) = w0; *(u32x4*)(l + row * KS + c16 + 8) = w1;
}
DI int kth_bit4(unsigned mask, int k) {
    unsigned x = mask;
    x = (k >= 1) ? (x & (x - 1u)) : x;
    x = (k >= 2) ? (x & (x - 1u)) : x;
    x = (k >= 3) ? (x & (x - 1u)) : x;
    return __builtin_ctz(x ? x : mask);
}
DI unsigned long long strip4(unsigned long long m, int k) {
    for (int i = 0; i < k; ++i) { m &= m - 1ull; m &= m - 1ull; m &= m - 1ull; m &= m - 1ull; }
    return m;
}
DI unsigned tok4(unsigned long long m) {
    const unsigned t0 = __builtin_ctzll(m); m &= m - 1ull;
    const unsigned t1 = m ? __builtin_ctzll(m) : t0; m &= m - 1ull;
    const unsigned t2 = m ? __builtin_ctzll(m) : t0; m &= m - 1ull;
    const unsigned t3 = m ? __builtin_ctzll(m) : t0;
    return t0 | (t1 << 8) | (t2 << 16) | (t3 << 24);
}
DI void nsa_b_cgroup(const bf16_t* Ks, const bf16_t* Vs, float* Mst, float* Lst, bf16_t* Ost, const bf16x8 q0, const bf16x8 q1, int tloc, bool valid, bool masked, bool diag,
                     int r, int lr, int lg, const bf16x8 ones) {
    const int col = tloc * 4 + r;
    float m = Mst[col];
    f32x4 L; { const float lo = Lst[col]; L = (f32x4){lo, lo, lo, lo}; }
    u32x2 ow[4];
#pragma unroll
    for (int db = 0; db < 4; ++db) ow[db] = *(const u32x2*)(Ost + col * OST + 16 * db + 4 * lg);
    bf16x8 ka[4][2];
#pragma unroll
    for (int kb = 0; kb < 4; ++kb)
#pragma unroll
        for (int ks = 0; ks < 2; ++ks) ka[kb][ks] = *(const bf16x8*)(Ks + (16 * kb + lr) * KS + 32 * ks + 8 * lg);
    const float msafe = (m == NEGINF) ? 0.f : m;
    const f32x4 cinit = {-msafe, -msafe, -msafe, -msafe};
    f32x4 S[4];
#pragma unroll
    for (int kb = 0; kb < 4; ++kb) {
        S[kb] = MFMA16(ka[kb][0], q0, cinit);
        S[kb] = MFMA16(ka[kb][1], q1, S[kb]);
    }
    s16x4 vlo[2][4], vhi[2][4];
#pragma unroll
    for (int s2 = 0; s2 < 2; ++s2)
#pragma unroll
        for (int db = 0; db < 4; ++db) {
            const bf16_t* vq = Vs + (16 * db + lr) * KS + 32 * s2 + 4 * lg;
            vlo[s2][db] = *(const s16x4*)vq; vhi[s2][db] = *(const s16x4*)(vq + 16);
        }
    f32x4 O[4];
#pragma unroll
    for (int db = 0; db < 4; ++db) O[db] = (f32x4){bflo(ow[db].x), bfhi(ow[db].x), bflo(ow[db].y), bfhi(ow[db].y)};
    if (diag) {
#pragma unroll
        for (int kb = 0; kb < 4; ++kb)
#pragma unroll
            for (int jj = 0; jj < 4; ++jj) S[kb][jj] = ((16 * kb + 4 * lg + jj) <= tloc) ? S[kb][jj] : NEGINF;
    }
    float mx = NEGINF;
#pragma unroll
    for (int kb = 0; kb < 4; ++kb)
#pragma unroll
        for (int jj = 0; jj < 4; ++jj) mx = fmaxf(mx, S[kb][jj]);
    mx = xrow16_max(mx);
    if (__any((m == NEGINF) ? (mx != NEGINF) : (mx > 8.0f))) {
        const float mnew = fmaxf(m, mx + msafe), msn = (mnew == NEGINF) ? 0.f : mnew;
        const float alpha = __builtin_amdgcn_exp2f(m - msn), delta = msn - msafe;
        m = mnew;
        L *= alpha;
#pragma unroll
        for (int db = 0; db < 4; ++db) O[db] *= alpha;
#pragma unroll
        for (int kb = 0; kb < 4; ++kb) S[kb] -= delta;
    }
#pragma unroll
    for (int s2 = 0; s2 < 2; ++s2) {
        u32x4 pw;
        pw.x = pack2(__builtin_amdgcn_exp2f(S[2 * s2][0]), __builtin_amdgcn_exp2f(S[2 * s2][1]));
        pw.y = pack2(__builtin_amdgcn_exp2f(S[2 * s2][2]), __builtin_amdgcn_exp2f(S[2 * s2][3]));
        pw.z = pack2(__builtin_amdgcn_exp2f(S[2 * s2 + 1][0]), __builtin_amdgcn_exp2f(S[2 * s2 + 1][1]));
        pw.w = pack2(__builtin_amdgcn_exp2f(S[2 * s2 + 1][2]), __builtin_amdgcn_exp2f(S[2 * s2 + 1][3]));
        const bf16x8 pf = __builtin_bit_cast(bf16x8, pw);
        L = MFMA16(ones, pf, L);
#pragma unroll
        for (int db = 0; db < 4; ++db) {
            const bf16x8 a = __builtin_shufflevector(vlo[s2][db], vhi[s2][db], 0, 1, 2, 3, 4, 5, 6, 7);
            O[db] = MFMA16(a, pf, O[db]);
        }
    }
    if (valid) {
#pragma unroll
        for (int db = 0; db < 4; ++db) {
            u32x2 w; w.x = pack2(O[db][0], O[db][1]); w.y = pack2(O[db][2], O[db][3]);
            *(u32x2*)(Ost + col * OST + 16 * db + 4 * lg) = w;
        }
        if (lg == 0) { Mst[col] = m; Lst[col] = L[0]; }
    }
}
DI void phase_nsa_b(const Params& p, char* smem, const int dry_i) {
    const bool dry = dry_i != 0;
    bf16_t* Tl = (bf16_t*)smem;
    unsigned* tmask = (unsigned*)(Tl + NB_ST * NB_TILE);
    float* Mst = (float*)(tmask + 512 + 64);
    float* Lst = Mst + 256;
    bf16_t* Ost = (bf16_t*)(Lst + 256);
    unsigned* ptab = (unsigned*)(Ost + 256 * OST);
    const int tid = threadIdx.x, lane = tid & 63, wid = tid >> 6, lr = lane & 15, lg = lane >> 4, r = lr & 3, tsl = lr >> 2;
    const int grp = blockIdx.x & 7, rank = blockIdx.x >> 3, nrank = (gridDim.x - grp + 7) >> 3;
    const int bg = grp, b = bg >> 2, g = bg & 3;
    const short one = (short)0x3F80;
    const bf16x8 ones = {one, one, one, one, one, one, one, one};
    for (int round = 0; round * nrank < 256; ++round) {
        const int li = (round & 1) ? (round * nrank + (nrank - 1 - rank)) : (round * nrank + rank);
        if (li >= 256) continue;
        const int tile = 255 - li, t0 = tile * 64, cur = tile;
        __syncthreads();
        for (int i = tid; i < 512; i += 256) tmask[i] = 0u;
        Mst[tid] = NEGINF; Lst[tid] = 0.f;
        for (int i = tid; i < 256 * OST * 2 / 16; i += 256) ((u32x4*)Ost)[i] = (u32x4){0u, 0u, 0u, 0u};
        __syncthreads();
        {
            const int tk = tid >> 2;
            const int* sp = p.sel + (((size_t)b * SEQ + t0 + tk) * 4 + g) * 16 + 4 * (tid & 3);
#pragma unroll
            for (int i = 0; i < 4; ++i) atomicOr(&tmask[sp[i] * 2 + (tk >> 5)], 1u << (tk & 31));
        }
        const unsigned char* Kg = (const unsigned char*)p.kslc + (size_t)bg * SEQ * 64;
        const unsigned char* Vg = (const unsigned char*)p.vslcT + (size_t)bg * 256 * 4096;
        const bf16_t* qbase = p.q0 + ((size_t)b * SEQ + t0) * 1024 + (g * 4 + r) * 64 + 8 * lg;
        u32x4 rk0, rv0, rk1, rv1;
        rk0 = *(const u32x4*)(Kg + tid * 16); rv0 = *(const u32x4*)(Vg + tid * 16);
        { const size_t o = (size_t)min(1, cur) * 4096 + tid * 16; rk1 = *(const u32x4*)(Kg + o); rv1 = *(const u32x4*)(Vg + o); }
        __syncthreads();
        {
            unsigned long long m = ((unsigned long long)tmask[tid * 2 + 1] << 32) | tmask[tid * 2];
#pragma unroll
            for (int gi = 0; gi < 4; ++gi) {
                ptab[tid * 4 + ((gi + tid) & 3)] = m ? tok4(m) : 0u;
                m &= m - 1ull; m &= m - 1ull; m &= m - 1ull; m &= m - 1ull;
            }
        }
        fp8_tile_st(Tl, rk0); fp8_tile_st(Tl + 64 * KS, rv0);
        { const size_t o = (size_t)min(2, cur) * 4096 + tid * 16; rk0 = *(const u32x4*)(Kg + o); rv0 = *(const u32x4*)(Vg + o); }
        __syncthreads();
        const int wu = __builtin_amdgcn_readfirstlane(wid);
        unsigned long long Mn; int nrn, tokn; bf16x8 qn0, qn1;
        auto prep = [&](const int jn) __attribute__((always_inline)) {
            const unsigned lo = __builtin_amdgcn_readfirstlane(tmask[jn * 2]), hi = __builtin_amdgcn_readfirstlane(tmask[jn * 2 + 1]);
            const unsigned pk = __builtin_amdgcn_readfirstlane(ptab[min(jn, 255) * 4 + wu]);
            Mn = ((unsigned long long)hi << 32) | lo;
            nrn = (jn <= cur) ? __builtin_popcountll(Mn) - 4 * ((wu - jn) & 3) : 0;
            tokn = (nrn > 0) ? ((pk >> (8 * tsl)) & 0xffu) : 0;
            qn0 = *(const bf16x8*)(qbase + (size_t)tokn * 1024); qn1 = *(const bf16x8*)(qbase + (size_t)tokn * 1024 + 32);
        };
        prep(0);
        auto iter = [&](const int j, u32x4& rk, u32x4& rv) __attribute__((always_inline)) {
            const unsigned long long Mc = Mn; const int nrc = nrn, tokc = tokn; const bf16x8 qc0 = qn0, qc1 = qn1;
            prep(j + 1);
            { bf16_t* Tn = Tl + ((j + 1) & 1) * NB_TILE; fp8_tile_st(Tn, rk); fp8_tile_st(Tn + 64 * KS, rv); }
            { const size_t o = (size_t)min(j + 3, cur) * 4096 + tid * 16; rk = *(const u32x4*)(Kg + o); rv = *(const u32x4*)(Vg + o); }
            if (nrc > 0 && dry_i != 2) {
                const bool diag = (j == cur);
                const bf16_t* Kq = Tl + (j & 1) * NB_TILE; const bf16_t* Vq = Kq + 64 * KS;
                nsa_b_cgroup(Kq, Vq, Mst, Lst, Ost, qc0, qc1, tokc, tsl < nrc, true, diag, r, lr, lg, ones);
                if (nrc > 16) {
                    unsigned long long mg = strip4(Mc, (wu - j) & 3);
                    int nrem = nrc;
                    while (nrem > 16) {
                        mg = strip4(mg, 4); nrem -= 16;
                        const unsigned pk = tok4(mg);
                        const int tl = (pk >> (8 * tsl)) & 0xffu;
                        const bf16x8 a0 = *(const bf16x8*)(qbase + (size_t)tl * 1024), a1 = *(const bf16x8*)(qbase + (size_t)tl * 1024 + 32);
                        nsa_b_cgroup(Kq, Vq, Mst, Lst, Ost, a0, a1, tl, tsl < nrem, true, diag, r, lr, lg, ones);
                    }
                }
            }
            __syncthreads();
        };
        {
            int j = 0;
            for (; j + 1 <= cur; j += 2) { iter(j, rk1, rv1); iter(j + 1, rk0, rv0); }
            if (j <= cur) iter(j, rk1, rv1);
        }
        {
            float gt[4]; u32x2 old[4][4];
#pragma unroll
            for (int c = 0; c < 4; ++c) {
                const int tloc = 16 * wid + 4 * c + tsl;
                const size_t tok = (size_t)b * SEQ + t0 + tloc;
                gt[c] = p.gates0[tok * 48 + 16 + g * 4 + r];
                const bf16_t* op = p.o0 + tok * 1024 + (g * 4 + r) * 64;
#pragma unroll
                for (int db = 0; db < 4; ++db) old[c][db] = *(const u32x2*)(op + 16 * db + 4 * lg);
            }
#pragma unroll
            for (int c = 0; c < 4; ++c) {
                const int tloc = 16 * wid + 4 * c + tsl, col = tloc * 4 + r;
                const float lt = Lst[col];
                const size_t tok = (size_t)b * SEQ + t0 + tloc;
                const float sc = (lt > 0.f) ? gt[c] / lt : 0.f;
                bf16_t* dp = (dry ? p.xn : p.o0) + tok * 1024 + (g * 4 + r) * 64;
#pragma unroll
                for (int db = 0; db < 4; ++db) {
                    const u32x2 ov = *(const u32x2*)(Ost + col * OST + 16 * db + 4 * lg);
                    u32x2 w;
                    w.x = pack2(bflo(old[c][db].x) + bflo(ov.x) * sc, bfhi(old[c][db].x) + bfhi(ov.x) * sc);
                    w.y = pack2(bflo(old[c][db].y) + bflo(ov.y) * sc, bfhi(old[c][db].y) + bfhi(ov.y) * sc);
                    *(u32x2*)(dp + 16 * db + 4 * lg) = w;
                }
            }
        }
    }
}

DI void ins16(unsigned (&t)[16], unsigned x) {
#pragma unroll
    for (int i = 0; i < 16; ++i) { const unsigned hi = max(t[i], x); x = min(t[i], x); t[i] = hi; }
}
DI void phase_topk(const Params& p, char* smem) {
    float* svals = (float*)smem;
    int* sidx = (int*)(svals + 256 * 17);
    const int tid = threadIdx.x;
    for (int blk = blockIdx.x; blk < NTOK / 16; blk += gridDim.x) {
        const int token = blk * 16 + (tid >> 4), list = tid & 15;
        {
            const size_t o = ((size_t)token * 16 + list) * 16;
            const float* tv = p.scores; const int* ti = (const int*)(p.scores + (size_t)NTOK * 256);
#pragma unroll
            for (int q = 0; q < 4; ++q) {
                const f32x4 vv = *(const f32x4*)(tv + o + 4 * q); const i32x4 ii = *(const i32x4*)(ti + o + 4 * q);
#pragma unroll
                for (int e = 0; e < 4; ++e) { svals[tid * 17 + 4 * q + e] = vv[e]; sidx[tid * 17 + 4 * q + e] = ii[e]; }
            }
        }
        __syncthreads();
        if ((tid & 1) == 0) {
            unsigned t2[16];
#pragma unroll
            for (int i = 0; i < 16; ++i) t2[i] = 0u;
#pragma unroll
            for (int i = 0; i < 16; ++i) {
                const float a = svals[tid * 17 + i];
#pragma unroll
                for (int j = 0; j < 16; ++j)
                    if ((i + 1) * (j + 1) <= 16) ins16(t2, (ordf(a + svals[(tid + 1) * 17 + j]) & 0xffffff00u) | (unsigned)(255 - (i * 16 + j)));
            }
            const float smax = unordf(t2[0] & 0xffffff00u);
            float e[16], se = 0.f;
#pragma unroll
            for (int k = 0; k < 16; ++k) { e[k] = __expf(unordf(t2[k] & 0xffffff00u) - smax); se += e[k]; }
            const float inv = 1.0f / se;
            const size_t ob = ((size_t)token * 8 + (list >> 1)) * 16;
#pragma unroll
            for (int k = 0; k < 16; ++k) {
                const int pos = 255 - (int)(t2[k] & 255u), i = pos >> 4, j = pos & 15;
                p.eidx[ob + k] = (int)(((unsigned)f2bf(e[k] * inv) << 16) | (unsigned)(sidx[tid * 17 + i] * 128 + sidx[(tid + 1) * 17 + j]));
            }
        }
        __syncthreads();
    }
}

DI void unpack16_fp8(const u32x4 r, float (&o)[16]) {
#pragma unroll
    for (int q = 0; q < 4; ++q) {
        const f32x2 lo = __builtin_amdgcn_cvt_pk_f32_fp8((int)r[q], false), hi = __builtin_amdgcn_cvt_pk_f32_fp8((int)r[q], true);
        o[4 * q] = lo.x; o[4 * q + 1] = lo.y; o[4 * q + 2] = hi.x; o[4 * q + 3] = hi.y;
    }
}
DI void reduce16(const float (&d)[16], int lane, float& c0, float& c1) {
    float a[8], b[4];
#pragma unroll
    for (int j = 0; j < 8; ++j) a[j] = swap32_add(d[j], d[j + 8]);
#pragma unroll
    for (int j = 0; j < 4; ++j) b[j] = swap16_add(a[j], a[j + 4]);
    const bool hi = lane & 8;
    const float k0 = hi ? b[2] : b[0], s0 = hi ? b[0] : b[2], k1 = hi ? b[3] : b[1], s1 = hi ? b[1] : b[3];
    c0 = octet_sum(k0 + dppf<0x128>(s0)); c1 = octet_sum(k1 + dppf<0x128>(s1));
}
DI float reduce8(const float (&d)[8], int lane) {
    float a[4], b[2];
#pragma unroll
    for (int j = 0; j < 4; ++j) a[j] = swap32_add(d[j], d[j + 4]);
#pragma unroll
    for (int j = 0; j < 2; ++j) b[j] = swap16_add(a[j], a[j + 2]);
    const bool hi = lane & 8;
    return octet_sum((hi ? b[1] : b[0]) + dppf<0x128>(hi ? b[0] : b[1]));
}
DI float dot16_fp8(const u32x4 r, const u32x4 x) {
    int acc = __builtin_amdgcn_sdot4((int)r.x, (int)x.x, 0, false);
    acc = __builtin_amdgcn_sdot4((int)r.y, (int)x.y, acc, false);
    acc = __builtin_amdgcn_sdot4((int)r.z, (int)x.z, acc, false);
    acc = __builtin_amdgcn_sdot4((int)r.w, (int)x.w, acc, false);
    return (float)acc;
}
DI float coef_pack(float c, int e) { return __uint_as_float(((unsigned)f2bf(c) << 16) | ((unsigned)e & 0xffffu)); }
DI void phase_peer_u(const Params& p, char* smem, const int dry_i) {
    const bool dry = dry_i != 0;
    const int lane = threadIdx.x & 63, wid = threadIdx.x >> 6;
    const int part0 = blockIdx.x & 7, rank = blockIdx.x >> 3, nrank = (gridDim.x - part0 + 7) >> 3;
    const int part = (dry_i == 4) ? (int)(xb_xcc_id() & 7u) : part0;
    int* Lbase = (int*)smem + wid * 768;
    float* cdst = dry ? p.scores : p.coef;
    const int j16 = ((lane >> 5) & 1) * 8 + ((lane >> 4) & 1) * 4 + ((lane >> 3) & 1) * 2 + (lane & 1);
    const int j8 = ((lane >> 5) & 1) * 4 + ((lane >> 4) & 1) * 2 + ((lane >> 3) & 1);
    const int tstride = nrank * 4;
    int t = rank * 4 + wid;
    int ev0 = 0, ev1 = 0; float gv0 = 0.f, gv1 = 0.f; u32x4 xraw = (u32x4){0u, 0u, 0u, 0u};
#define U_LOAD_RAW(tt) do { ev0 = p.eidx[(size_t)(tt) * 128 + lane]; ev1 = p.eidx[(size_t)(tt) * 128 + 64 + lane]; \
        xraw = *(const u32x4*)(p.xq8 + (size_t)(tt) * 1024 + 16 * lane); } while (0)
#define U_BUILD_LIST(buf, nout) do { int* L_idx_ = Lbase + (buf) * 384; float* L_gate_ = (float*)(L_idx_ + 128); int* L_pos_ = L_idx_ + 256; \
        const bool in0 = ((ev0 & 0xffff) >> 11) == part, in1 = ((ev1 & 0xffff) >> 11) == part; \
        const unsigned long long mk0 = __ballot(in0), mk1 = __ballot(in1); \
        const int n0_ = __popcll(mk0); nout = n0_ + __popcll(mk1); \
        asm volatile("" ::: "memory"); \
        if (in0) { const int r0 = __builtin_amdgcn_mbcnt_hi((unsigned)(mk0 >> 32), __builtin_amdgcn_mbcnt_lo((unsigned)mk0, 0u)); L_idx_[r0] = ev0 & 0xffff; L_gate_[r0] = __uint_as_float((unsigned)ev0 & 0xffff0000u); L_pos_[r0] = lane; } \
        if (in1) { const int r1 = n0_ + __builtin_amdgcn_mbcnt_hi((unsigned)(mk1 >> 32), __builtin_amdgcn_mbcnt_lo((unsigned)mk1, 0u)); L_idx_[r1] = ev1 & 0xffff; L_gate_[r1] = __uint_as_float((unsigned)ev1 & 0xffff0000u); L_pos_[r1] = 64 + lane; } \
        asm volatile("s_waitcnt lgkmcnt(0)" ::: "memory"); } while (0)
    int nC = 0; u32x4 xC = xraw; u32x4 rrA[16], rrB[16];
    {
        U_LOAD_RAW(t);
        U_BUILD_LIST(0, nC); xC = xraw;
        U_LOAD_RAW(min(t + tstride, NTOK - 1));
        const int* L_idx = Lbase;
#pragma unroll
        for (int j = 0; j < 16; ++j) rrA[j] = *(const u32x4*)(p.u8 + (size_t)(L_idx[j < nC ? j : 0] & 16383) * 1024 + 16 * lane);
    }
    auto step = [&](const int t, const int cbuf, u32x4 (&rC)[16], u32x4 (&rN)[16]) __attribute__((always_inline)) {
        const int tn = t + tstride;
        int nN = 0; U_BUILD_LIST(cbuf ^ 1, nN); const u32x4 xN = xraw;
        const int* L_idx = Lbase + cbuf * 384; const float* L_gate = (const float*)(L_idx + 128); const int* L_pos = L_idx + 256;
        const int* Ln = Lbase + (cbuf ^ 1) * 384;
        const int n = nC;
#define U_NEXT_ROWS() do { U_LOAD_RAW(min(tn + tstride, NTOK - 1)); \
        _Pragma("unroll") for (int j = 0; j < 16; ++j) rN[j] = *(const u32x4*)(p.u8 + (size_t)(Ln[j < nN ? j : 0] & 16383) * 1024 + 16 * lane); } while (0)
#define U_FIRST16() do { float d[16]; \
        _Pragma("unroll") for (int j = 0; j < 16; ++j) d[j] = dot16_fp8(rC[j], xC); \
        float c0, c1; reduce16(d, lane, c0, c1); \
        { const int sl = j16; if ((lane & 7) < 2 && sl < n) cdst[(size_t)t * 128 + L_pos[sl]] = coef_pack(gelu_tanh(((lane & 1) ? c1 : c0) * (1.0f / (U8_SCALE * X8_SCALE))) * L_gate[sl] * FP8_INV, L_idx[sl]); } } while (0)
        if (n > 16) {
            u32x4 r2[8];
#pragma unroll
            for (int j = 0; j < 8; ++j) { const int sl = 16 + j; r2[j] = *(const u32x4*)(p.u8 + (size_t)(L_idx[sl < n ? sl : 0] & 16383) * 1024 + 16 * lane); }
            U_NEXT_ROWS();
            U_FIRST16();
            {
                float d2[8];
#pragma unroll
                for (int j = 0; j < 8; ++j) d2[j] = dot16_fp8(r2[j], xC);
                const float tot2 = reduce8(d2, lane);
                const int sl = 16 + j8; if ((lane & 7) == 0 && sl < n) cdst[(size_t)t * 128 + L_pos[sl]] = coef_pack(gelu_tanh(tot2 * (1.0f / (U8_SCALE * X8_SCALE))) * L_gate[sl] * FP8_INV, L_idx[sl]);
            }
            for (int base = 24; base < n; base += 8) {
                float d2[8];
#pragma unroll
                for (int j = 0; j < 8; ++j) { const int sl = base + j; d2[j] = dot16_fp8(*(const u32x4*)(p.u8 + (size_t)(L_idx[sl < n ? sl : 0] & 16383) * 1024 + 16 * lane), xC); }
                const float tot2 = reduce8(d2, lane);
                const int sl = base + j8; if ((lane & 7) == 0 && sl < n) cdst[(size_t)t * 128 + L_pos[sl]] = coef_pack(gelu_tanh(tot2 * (1.0f / (U8_SCALE * X8_SCALE))) * L_gate[sl] * FP8_INV, L_idx[sl]);
            }
        } else {
            U_NEXT_ROWS();
            if (n > 0) U_FIRST16();
        }
#undef U_NEXT_ROWS
#undef U_FIRST16
        asm volatile("" ::: "memory");
        nC = nN; xC = xN;
    };
    {
        const int nw = __builtin_amdgcn_readfirstlane((NTOK - t + tstride - 1) / tstride);
        int it = 0;
        for (; it + 2 <= nw; it += 2) { step(t, 0, rrA, rrB); t += tstride; step(t, 1, rrB, rrA); t += tstride; }
        if (it < nw) step(t, 0, rrA, rrB);
    }
}
DI void phase_peer_v(const Params& p, const bool dry) {
    const int lane = threadIdx.x & 63, wid = threadIdx.x >> 6, pg = lane >> 3, li = lane & 7;
    const int sl = blockIdx.x & 7, rank = blockIdx.x >> 3, nrank = (gridDim.x - sl + 7) >> 3;
    const unsigned char* vt = p.v8s + (size_t)sl * 16384 * 128 + 16 * li;
    int t = rank * 4 + wid;
    const unsigned* cw = (const unsigned*)p.coef;
    unsigned w0 = 0u, w1 = 0u;
    if (t < NTOK) { w0 = cw[(size_t)t * 128 + lane]; w1 = cw[(size_t)t * 128 + 64 + lane]; }
    for (; t < NTOK; t += nrank * 4) {
        const int tn = t + nrank * 4;
        const size_t o = (size_t)t * 1024 + 128 * sl + 16 * li + 2 * pg;
        f32x2 acc[8];
#pragma unroll
        for (int j = 0; j < 8; ++j) acc[j] = (f32x2){0.f, 0.f};
        u32x4 r[16]; float c[16];
#pragma unroll
        for (int k = 0; k < 16; ++k) {
            const int src = (8 * k + pg) & 63;
            const unsigned w = (unsigned)__shfl((int)(k < 8 ? w0 : w1), src);
            c[k] = __uint_as_float(w & 0xffff0000u);
            r[k] = *(const u32x4*)(vt + (size_t)(w & 0xffffu) * 128);
        }
        __builtin_amdgcn_sched_barrier(0);
        const bf16_t* rp = res_row(p.out, (size_t)t) + 128 * sl + 16 * li + 2 * pg;
        const unsigned curw = *(const unsigned*)rp;
        f32x2 cur = {bflo(curw), bfhi(curw)};
        const size_t tnc = (size_t)min(tn, NTOK - 1) * 128 + lane;
        const unsigned nw0 = cw[tnc], nw1 = cw[tnc + 64];
        __builtin_amdgcn_sched_barrier(0);
#pragma unroll
        for (int k = 0; k < 16; ++k) {
            f32x2 cp = {c[k & ~1], c[k | 1]};
            asm volatile("" : "+v"(cp));
            const f32x2 ck = (k & 1) ? __builtin_shufflevector(cp, cp, 1, 1) : __builtin_shufflevector(cp, cp, 0, 0);
#pragma unroll
            for (int q = 0; q < 4; ++q) {
                acc[2 * q] += ck * __builtin_amdgcn_cvt_pk_f32_fp8((int)r[k][q], false);
                acc[2 * q + 1] += ck * __builtin_amdgcn_cvt_pk_f32_fp8((int)r[k][q], true);
            }
        }
        float a8[8], a4[4], a2[2];
#pragma unroll
        for (int j = 0; j < 4; ++j) { a8[2 * j] = swap32_add(acc[j].x, acc[j + 4].x); a8[2 * j + 1] = swap32_add(acc[j].y, acc[j + 4].y); }
#pragma unroll
        for (int j = 0; j < 4; ++j) a4[j] = swap16_add(a8[j], a8[j + 4]);
        {
            const bool hi = pg & 1;
            a2[0] = (hi ? a4[2] : a4[0]) + dppf<0x128>(hi ? a4[0] : a4[2]);
            a2[1] = (hi ? a4[3] : a4[1]) + dppf<0x128>(hi ? a4[1] : a4[3]);
        }
        cur.x += a2[0]; cur.y += a2[1];
        *(unsigned*)(dry ? (bf16_t*)(p.scores + o) : res_row(p.out, (size_t)t) + 128 * sl + 16 * li + 2 * pg) = pack2(cur.x, cur.y);
        w0 = nw0; w1 = nw1;
    }
}

DI void phase_cumsum(const Params& p, char* smem) {
    float* part = (float*)smem;
    const int tid = threadIdx.x;
    for (int seq = blockIdx.x; seq < 32; seq += gridDim.x) {
        float* c = p.cfox + (size_t)seq * SEQ + tid * 64;
        float s = 0.f;
        for (int i = 0; i < 64; i += 4) { const f32x4 v = *(const f32x4*)(c + i); s += (v[0] + v[1]) + (v[2] + v[3]); }
        __syncthreads();
        part[tid] = s;
        __syncthreads();
        float run = 0.f;
        for (int i = 0; i < tid; ++i) run += part[i];
        for (int i = 0; i < 64; i += 4) {
            f32x4 v = *(const f32x4*)(c + i);
            v[0] += run; v[1] += v[0]; v[2] += v[1]; v[3] += v[2]; run = v[3];
            *(f32x4*)(c + i) = v;
        }
    }
}

constexpr int N_PHASES = 23;
#ifndef PROBE_PHASE
#define PROBE_PHASE -1
#endif
#ifndef PROBE_DRY
#define PROBE_DRY 1
#endif
constexpr int cmax(int a, int b) { return a > b ? a : b; }
constexpr int LDS_BYTES = 16 + 64 + cmax(cmax(NSB_LDS, 384 * GS * 2), 2 * 64 * KS * 2 + 32 * IST * 4);
static_assert(LDS_BYTES >= 16 + 256 * 17 * 8, "topk tables must fit");

__global__ void __launch_bounds__(256, 2) mega(Params p, int ph_lo, int ph_hi, int dry_i) {
    const bool dry = dry_i != 0;
    extern __shared__ __attribute__((aligned(16))) char smem_all[];
    char* smem = smem_all + 16;
    const bool multi = (ph_hi - ph_lo) > 1;
    XcdBarrier bar;
    if (multi) {
        if (threadIdx.x == 0) *(uint4*)smem_all = make_uint4(0u, 0u, 0u, 0u);
        __syncthreads();
        bar = xcd_barrier_post(p.bar, (volatile LAS unsigned*)smem_all);
    }
#define PHASE(i, ...) if (ph_lo <= (i) && (i) < ph_hi) { __VA_ARGS__; if ((i) + 1 < ph_hi) xcd_barrier(bar); }
    PHASE(0, phase_prologue(p))
    PHASE(1, phase_gemm_in0(p, smem))
    PHASE(2, phase_cmp1(p, smem))
    PHASE(3, phase_cmp2(p, smem))
    PHASE(4, phase_nsa_a(p, smem))
    PHASE(5, phase_nsa_b(p, smem, dry_i))
    PHASE(6, phase_gemm_out<false>(p.o0, p.wt_out0, p.x, p.out, smem))
    PHASE(7, rmsnorm_pipe<1, true>(p.out, p.l0_ffn_norm, p.xn, nullptr, p.xq8))
    PHASE(8, phase_gemm_scores(p, p.weff0, smem))
    PHASE(10, phase_peer_u(p, smem, dry_i))
    PHASE(11, phase_peer_v(p, dry))
    PHASE(12, { rmsnorm_pipe<0, true>(p.out, p.l1_attn_norm, p.xn, nullptr, nullptr);
                const int gtid = blockIdx.x * blockDim.x + threadIdx.x, gsz = gridDim.x * blockDim.x;
                convert_tables_fp8(p.l1_u, p.l1_v, p.u8, p.v8s, gtid, gsz); if (gtid < 64) p.nrm[gtid] = 0u; })
    PHASE(13, phase_gemm_in1(p, smem))
    PHASE(14, phase_cumsum(p, smem))
    PHASE(15, phase_fox(p, smem))
    PHASE(16, phase_gemm_out<true>(p.o1, p.wt_out1, p.out, p.out, smem))
    PHASE(17, rmsnorm_pipe<1, true>(p.out, p.l1_ffn_norm, p.xn, nullptr, p.xq8))
    PHASE(18, phase_gemm_scores(p, p.weff1, smem))
    PHASE(20, phase_peer_u(p, smem, dry_i))
    PHASE(21, phase_peer_v(p, dry))
    PHASE(22, rmsnorm_pipe<2, true>(p.out, p.final_norm, nullptr, p.out, nullptr))
#undef PHASE
}

#ifndef MK_ONE_LAUNCH
#define MK_ONE_LAUNCH 1
#endif
extern "C" void kernel_launch(void* const* d_in, const int* in_sizes, int n_in, void* d_out, int out_size, void* d_ws, size_t ws_size, hipStream_t stream) {
    (void)in_sizes; (void)n_in; (void)out_size;
    Params p{};
    const float* const* in = (const float* const*)d_in;
    p.x = in[0]; p.l0_attn_norm = in[1]; p.l0_w_in = in[2]; p.l0_pe_k = in[3]; p.l0_w1_k = in[4]; p.l0_w2_k = in[5]; p.l0_pe_v = in[6]; p.l0_w1_v = in[7]; p.l0_w2_v = in[8];
    p.l0_w_out = in[9]; p.l0_ffn_norm = in[10]; p.l0_wq = in[11]; p.l0_keys = in[12]; p.l0_u = in[13]; p.l0_v = in[14];
    p.l1_attn_norm = in[15]; p.l1_w_in = in[16]; p.l1_f_bias = in[17]; p.l1_w_out = in[18]; p.l1_ffn_norm = in[19]; p.l1_wq = in[20]; p.l1_keys = in[21]; p.l1_u = in[22]; p.l1_v = in[23];
    p.final_norm = in[24];
    p.out = (float*)d_out;
    char* w = (char*)d_ws; size_t off = 0;
    auto take = [&](size_t bytes) { char* r = w + off; off += (bytes + 255) & ~(size_t)255; return r; };
    p.bar = (unsigned*)take(XCD_BAR_WORDS * 4);
    p.rope = (float2*)take((size_t)SEQ * 32 * 8);
    p.wt_in0 = (bf16_t*)take((size_t)NSA_NP * 1024 * 2); p.wt_out0 = (bf16_t*)take((size_t)1024 * 1024 * 2);
    p.wq0b = (bf16_t*)take((size_t)1024 * 2048 * 2); p.keys0b = (bf16_t*)take((size_t)16 * 128 * 128 * 2); p.weff0 = (bf16_t*)take((size_t)2048 * 1024 * 2);
    p.wt_in1 = (bf16_t*)take((size_t)FOX_NP * 1024 * 2); p.wt_out1 = (bf16_t*)take((size_t)1024 * 1024 * 2);
    p.wq1b = (bf16_t*)take((size_t)1024 * 2048 * 2); p.keys1b = (bf16_t*)take((size_t)16 * 128 * 128 * 2); p.weff1 = (bf16_t*)take((size_t)2048 * 1024 * 2);
    p.w1t = (bf16_t*)take((size_t)8 * 128 * 2048 * 2); p.w2t = (bf16_t*)take((size_t)8 * 128 * 128 * 2); p.b1 = (float*)take(16 * 1024 * 4);
    p.u8 = (unsigned char*)take((size_t)16384 * 1024); p.v8s = (unsigned char*)take((size_t)16384 * 1024); p.coef = (float*)take((size_t)NTOK * 128 * 4);
    p.xn = (bf16_t*)take((size_t)NTOK * 1024 * 2); p.xq8 = (unsigned char*)take((size_t)NTOK * 1024);
    p.eidx = (int*)take((size_t)NTOK * 128 * 4); p.egate = (float*)take((size_t)NTOK * 128 * 4);
    p.cfox = (float*)take((size_t)32 * SEQ * 4); p.nrm = (unsigned*)take(256);
    char* act = take((size_t)256 << 20);
    {
        size_t a = 0; auto tk = [&](size_t bytes) { char* r = act + a; a += (bytes + 255) & ~(size_t)255; return r; };
        p.q0 = (bf16_t*)tk((size_t)NTOK * 1024 * 2);
        p.kcin = (bf16_t*)tk((size_t)8 * SEQ * 64 * 2); p.vcin = (bf16_t*)tk((size_t)8 * SEQ * 64 * 2); p.kslc = (bf16_t*)tk((size_t)8 * SEQ * 64 * 2);
        p.vslcT = (bf16_t*)tk((size_t)8 * SEQ * 64 * 2); p.kwin = (bf16_t*)tk((size_t)8 * SEQ * 64 * 2); p.vwinT = (bf16_t*)tk((size_t)8 * SEQ * 64 * 2);
        p.o0 = (bf16_t*)tk((size_t)NTOK * 1024 * 2);
        p.gates0 = (float*)tk((size_t)NTOK * 48 * 4); p.sel = (int*)tk((size_t)NTOK * 64 * 4);
        p.kcmp = (bf16_t*)tk((size_t)8 * 1024 * 64 * 2); p.vcmpT = (bf16_t*)tk((size_t)8 * 1024 * 64 * 2); p.hid = (bf16_t*)tk((size_t)16 * 1024 * 128 * 2);
        if (a > ((size_t)256 << 20)) { fprintf(stderr, "activation overlay too large\n"); return; }
        p.scores = (float*)act;
        p.q1 = (bf16_t*)act; p.k1 = p.q1 + (size_t)NTOK * 1024; p.v1T = p.k1 + (size_t)NTOK * 1024; p.o1 = p.v1T + (size_t)NTOK * 1024;
    }
    if (off > ws_size) { fprintf(stderr, "workspace too small: need %zu have %zu\n", off, ws_size); return; }

    static int grid = 0;
    if (!grid) {
        int dev = 0, cus = 0, per_cu = 0;
        hipGetDevice(&dev);
        hipDeviceGetAttribute(&cus, hipDeviceAttributeMultiprocessorCount, dev);
        if (hipFuncSetAttribute((const void*)mega, hipFuncAttributeMaxDynamicSharedMemorySize, LDS_BYTES) != hipSuccess) fprintf(stderr, "kernel_launch: hipFuncSetAttribute(%d B LDS) failed\n", LDS_BYTES);
        hipOccupancyMaxActiveBlocksPerMultiprocessor(&per_cu, mega, 256, LDS_BYTES);
        if (per_cu > 2) per_cu = 2;
        if (per_cu < 1) per_cu = 1;
        grid = cus * per_cu;
    }
#if PROBE_PHASE >= 0
    for (int i = 0; i < N_PHASES; ++i) {
        if (i == PROBE_PHASE) hipLaunchKernelGGL(mega, dim3(grid), dim3(256), LDS_BYTES, stream, p, i, i + 1, PROBE_DRY);
        hipLaunchKernelGGL(mega, dim3(grid), dim3(256), LDS_BYTES, stream, p, i, i + 1, 0);
    }
#elif MK_ONE_LAUNCH
    hipMemsetAsync(p.bar, 0, XCD_BAR_WORDS * 4, stream);
    hipLaunchKernelGGL(mega, dim3(grid), dim3(256), LDS_BYTES, stream, p, 0, N_PHASES, 0);
#else
    for (int i = 0; i < N_PHASES; ++i) hipLaunchKernelGGL(mega, dim3(grid), dim3(256), LDS_BYTES, stream, p, i, i + 1, 0);
#endif
}
```
